# Optimizing an MI355X kernel written in HIP

```python
import math
import jax, jax.numpy as jnp
from jax import lax
import numpy as np

D_MODEL = 2048
BATCH = 2
SEQ = 8192
DEPTH = 2

CHUNK = 64
Q_BLOCK = 128
HA = 8
A_NOPE = 128
A_ROPE = 64
A_V = 128
Q_RANK = 384
KV_RANK = 128
ROPE_THETA = 10000.0
HB = 4
B_DH = 64
HC = 4
C_DH = 128
LEFT_CHUNKS = 8
REL_CLIP = 256
REL_SIZE = REL_CLIP + CHUNK
MIX_WIDTH = HA * A_V + HB * 2 * B_DH + HC * C_DH
IN_SIZES = (Q_RANK, KV_RANK, A_ROPE,
            HB * 2 * B_DH, HB * 2 * B_DH, HB * 2 * B_DH,
            HC * C_DH, HC * C_DH, HC * C_DH)
IN_WIDTH = sum(IN_SIZES)
D_FF = 4 * D_MODEL
EPS = 1e-6
NEG = -1e30

kernel_name = "hybrid_mla_diff_chunkband_stream_encoder"


def rms_norm(x, g):
    xf = x.astype(jnp.float32)
    y = xf * lax.rsqrt(jnp.mean(xf * xf, axis=-1, keepdims=True) + EPS)
    return (y * g.astype(jnp.float32)).astype(x.dtype)


def apply_rope(x, pos):
    half = x.shape[-1] // 2
    inv_freq = ROPE_THETA ** (-jnp.arange(half, dtype=jnp.float32) / half)
    ang = pos.astype(jnp.float32)[:, None] * inv_freq[None, :]
    cos = jnp.cos(ang)[:, None, :]
    sin = jnp.sin(ang)[:, None, :]
    xf = x.astype(jnp.float32)
    x1, x2 = xf[..., :half], xf[..., half:]
    return jnp.concatenate([x1 * cos - x2 * sin, x2 * cos + x1 * sin], axis=-1).astype(x.dtype)


def chunk_causal_mask(q_pos, seq):
    k_chunk = jnp.arange(seq) // CHUNK
    return k_chunk[None, :] <= (q_pos // CHUNK)[:, None]


def sweep_query_blocks(block_fn, q):
    b, h, s = q.shape[:3]
    nblk = s // Q_BLOCK
    qb = jnp.moveaxis(q.reshape((b, h, nblk, Q_BLOCK) + q.shape[3:]), 2, 0)
    out = lax.map(lambda a: block_fn(a[0], a[1]), (qb, jnp.arange(nblk)))
    return out.transpose(1, 0, 3, 2, 4).reshape(b, s, h * out.shape[-1])


def mla_mixer(c_q, c_kv, k_rope, q_norm, kv_norm, w_uq, w_ukv):
    b, s, _ = c_q.shape
    pos = jnp.arange(s)
    q = (rms_norm(c_q, q_norm) @ w_uq).reshape(b, s, HA, A_NOPE + A_ROPE)
    q = jnp.concatenate([q[..., :A_NOPE], apply_rope(q[..., A_NOPE:], pos)], axis=-1)
    kv = (rms_norm(c_kv, kv_norm) @ w_ukv).reshape(b, s, HA, A_NOPE + A_V)
    kr = apply_rope(k_rope[:, :, None, :], pos)
    k = jnp.concatenate([kv[..., :A_NOPE], jnp.broadcast_to(kr, (b, s, HA, A_ROPE))], axis=-1)
    q = q.transpose(0, 2, 1, 3)
    k = k.transpose(0, 2, 1, 3)
    v = kv[..., A_NOPE:].transpose(0, 2, 1, 3)
    scale = (A_NOPE + A_ROPE) ** -0.5

    def block(qb, blk):
        q_pos = blk * Q_BLOCK + jnp.arange(Q_BLOCK)
        sc = jnp.einsum('bhqd,bhkd->bhqk', qb, k).astype(jnp.float32) * scale
        sc = jnp.where(chunk_causal_mask(q_pos, s), sc, NEG)
        p = jax.nn.softmax(sc, axis=-1).astype(v.dtype)
        return jnp.einsum('bhqk,bhkd->bhqd', p, v)

    return sweep_query_blocks(block, q)


def diff_mixer(q, k, v, lq1, lk1, lq2, lk2, subln, lam_init):
    b, s, _ = q.shape
    q = q.reshape(b, s, HB, 2, B_DH).transpose(0, 2, 1, 3, 4)
    k = k.reshape(b, s, HB, 2, B_DH).transpose(0, 2, 1, 3, 4)
    v = v.reshape(b, s, HB, 2 * B_DH).transpose(0, 2, 1, 3)
    f32 = jnp.float32
    lam = (jnp.exp(jnp.sum(lq1.astype(f32) * lk1.astype(f32)))
           - jnp.exp(jnp.sum(lq2.astype(f32) * lk2.astype(f32))) + lam_init)
    slopes = 2.0 ** (-8.0 * (jnp.arange(HB, dtype=f32) + 1.0) / HB)
    k_pos = jnp.arange(s)
    scale = B_DH ** -0.5

    def block(qb, blk):
        q_pos = blk * Q_BLOCK + jnp.arange(Q_BLOCK)
        sc = jnp.einsum('bhqnd,bhknd->nbhqk', qb, k).astype(f32) * scale
        dist = jnp.abs(q_pos[:, None] - k_pos[None, :]).astype(f32)
        sc = sc - slopes[:, None, None] * dist
        sc = jnp.where(chunk_causal_mask(q_pos, s), sc, NEG)
        p = jax.nn.softmax(sc, axis=-1)
        w = (p[0] - lam * p[1]).astype(v.dtype)
        o = jnp.einsum('bhqk,bhkd->bhqd', w, v)
        return rms_norm(o, subln) * (1.0 - lam_init)

    return sweep_query_blocks(block, q)


def chunk_band_mixer(q, k, v, rel_bias):
    b, s, _ = q.shape
    nc = s // CHUNK
    win = LEFT_CHUNKS + 1
    idx = jnp.arange(nc)[:, None] + jnp.arange(win)[None, :]

    def band(t):
        t = t.reshape(b, nc, CHUNK, HC, C_DH)
        t = jnp.pad(t, ((0, 0), (LEFT_CHUNKS, 0), (0, 0), (0, 0), (0, 0)))
        return t[:, idx].reshape(b, nc, win * CHUNK, HC, C_DH)

    qc = q.reshape(b, nc, CHUNK, HC, C_DH)
    kb, vb = band(k), band(v)
    valid = (jnp.arange(nc)[:, None] - LEFT_CHUNKS + jnp.arange(win)[None, :]) >= 0
    valid = jnp.repeat(valid, CHUNK, axis=1)
    rel = LEFT_CHUNKS * CHUNK + jnp.arange(CHUNK)[:, None] - jnp.arange(win * CHUNK)[None, :]
    rel_idx = jnp.clip(rel, -(CHUNK - 1), REL_CLIP) + (CHUNK - 1)
    bias = rel_bias[:, rel_idx].astype(jnp.float32)
    sc = jnp.einsum('bcqhd,bckhd->bchqk', qc, kb).astype(jnp.float32) * (C_DH ** -0.5)
    sc = sc + bias[None, None]
    sc = jnp.where(valid[None, :, None, None, :], sc, NEG)
    p = jax.nn.softmax(sc, axis=-1).astype(vb.dtype)
    o = jnp.einsum('bchqk,bckhd->bcqhd', p, vb)
    return o.reshape(b, s, HC * C_DH)


def setup_inputs(seed: int = 0) -> dict:
    key = jax.random.key(seed)
    ks = jax.random.split(key, 20)
    f32 = jnp.float32
    nrm = lambda k, shape, s: jax.random.normal(k, shape, f32) * s
    gain = lambda k, shape: 1.0 + 0.02 * jax.random.normal(k, shape, f32)
    return {
        "x": nrm(ks[0], (BATCH, SEQ, D_MODEL), 1.0),
        "attn_norm": gain(ks[1], (DEPTH, D_MODEL)),
        "w_in": nrm(ks[2], (DEPTH, D_MODEL, IN_WIDTH), D_MODEL ** -0.5),
        "q_a_norm": gain(ks[3], (DEPTH, Q_RANK)),
        "kv_a_norm": gain(ks[4], (DEPTH, KV_RANK)),
        "w_uq": nrm(ks[5], (DEPTH, Q_RANK, HA * (A_NOPE + A_ROPE)), Q_RANK ** -0.5),
        "w_ukv": nrm(ks[6], (DEPTH, KV_RANK, HA * (A_NOPE + A_V)), KV_RANK ** -0.5),
        "lambda_q1": nrm(ks[7], (DEPTH, B_DH), 0.1),
        "lambda_k1": nrm(ks[8], (DEPTH, B_DH), 0.1),
        "lambda_q2": nrm(ks[9], (DEPTH, B_DH), 0.1),
        "lambda_k2": nrm(ks[10], (DEPTH, B_DH), 0.1),
        "diff_subln": gain(ks[11], (DEPTH, 2 * B_DH)),
        "rel_bias": nrm(ks[12], (DEPTH, HC, REL_SIZE), 0.1),
        "w_o": nrm(ks[13], (DEPTH, MIX_WIDTH, D_MODEL), MIX_WIDTH ** -0.5),
        "mlp_norm": gain(ks[14], (DEPTH, D_MODEL)),
        "w_up": nrm(ks[15], (DEPTH, D_MODEL, D_FF), D_MODEL ** -0.5),
        "w_down": nrm(ks[16], (DEPTH, D_FF, D_MODEL), D_FF ** -0.5),
        "final_norm": gain(ks[17], (D_MODEL,)),
    }


def reference(x, attn_norm, w_in, q_a_norm, kv_a_norm, w_uq, w_ukv,
              lambda_q1, lambda_k1, lambda_q2, lambda_k2, diff_subln, rel_bias,
              w_o, mlp_norm, w_up, w_down, final_norm):
    split_points = np.cumsum(np.array(IN_SIZES))[:-1]
    for l in range(DEPTH):
        h = rms_norm(x, attn_norm[l])
        proj = h @ w_in[l]
        (c_q, c_kv, k_rope, qb, kb, vb, qc, kc, vc) = jnp.split(proj, split_points, axis=-1)
        out_a = mla_mixer(c_q, c_kv, k_rope, q_a_norm[l], kv_a_norm[l], w_uq[l], w_ukv[l])
        lam_init = 0.8 - 0.6 * math.exp(-0.3 * l)
        out_b = diff_mixer(qb, kb, vb, lambda_q1[l], lambda_k1[l], lambda_q2[l],
                           lambda_k2[l], diff_subln[l], lam_init)
        out_c = chunk_band_mixer(qc, kc, vc, rel_bias[l])
        mixed = jnp.concatenate([out_a, out_b, out_c], axis=-1)
        x = x + mixed @ w_o[l]
        h = rms_norm(x, mlp_norm[l])
        x = x + jnp.square(jax.nn.relu(h @ w_up[l])) @ w_down[l]
    return rms_norm(x, final_norm)
```

```cpp
#include <hip/hip_runtime.h>
#include <hip/hip_cooperative_groups.h>
#include <cstdio>
#include <cstdint>
namespace cg = cooperative_groups;
namespace pg8 {
#define PG8_LAS __attribute__((address_space(3)))
typedef unsigned short bf16_t;
typedef short bf16x8 __attribute__((ext_vector_type(8)));
typedef float f32x4 __attribute__((ext_vector_type(4)));
typedef unsigned u32x4 __attribute__((ext_vector_type(4)));
constexpr int BM = 256, BK = 64, HALF = 128, HTB = HALF * BK * 2  , STAGE_BYTES = 8 * HTB, NXCD = 8, WGM = 8;

__host__ __device__ __forceinline__ int lds_byte(int r, int c) { const int st = (r >> 4) * 2 + (c >> 5), rr = r & 15, cc = c & 31, ob = rr * 64 + cc * 2; return st * 1024 + (ob ^ (((ob >> 9) & 1) << 5)); }
__host__ __device__ __forceinline__ void stage_rc(int b, int& R, int& C) { const int st = b / 1024, sb = b % 1024, swz = sb ^ (((sb >> 9) & 1) << 5); R = (st >> 1) * 16 + swz / 64; C = (st & 1) * 32 + (swz % 64) / 2; }
__host__ __device__ __forceinline__ int perm32(int rho) { const int n = rho >> 4, i = rho & 15; return 8 * (i >> 2) + 4 * n + (i & 3); }

struct Unit { int pm, pn; };
struct Gemm { const bf16_t* A; const bf16_t* Bt; int M, N, K, lda; };

struct StaticOrder {
    int nM, nN, nwg, G, c;
    __host__ __device__ void init(int M, int N, int G_, int c_) { nM = M / BM; nN = N / BM; nwg = nM * nN; G = G_; c = c_; }
    __host__ __device__ bool next(int i, Unit& u) const {
        const long L = (long)i * G + c; if (L >= nwg) return false;
        int wgid = (int)L; { const int q = nwg / NXCD, r = nwg % NXCD, xcd = wgid % NXCD, off = wgid / NXCD; wgid = (xcd < r ? xcd * (q + 1) : r * (q + 1) + (xcd - r) * q) + off; }
        const int nig = WGM * nN, gid = wgid / nig, fm = gid * WGM, gsz = (nM - fm) < WGM ? (nM - fm) : WGM;
        u.pm = fm + ((wgid % nig) % gsz); u.pn = (wgid % nig) / gsz; return true;
    }
    __device__ __forceinline__ void a_ready(const Unit&) const {}
    __device__ __forceinline__ void done(const Unit&) const {}
};

__device__ __forceinline__ unsigned cvt_pk_bf16(float lo, float hi) { unsigned r; asm volatile("v_cvt_pk_bf16_f32 %0, %1, %2" : "=v"(r) : "v"(lo), "v"(hi)); return r; }
typedef float f32x2 __attribute__((ext_vector_type(2)));
template <int ACT, bool ROPE> struct EpiBf {
    static constexpr bool PERM = true, AFTER_DRAIN = false;
    bf16_t* O; int ldc; int rope_period, rope_start; const float* rope_tab; const PG8_LAS float* rs;
    __device__ __forceinline__ void operator()(const f32x4 (&acc)[2][2][4][2], const Unit& u, int wr, int wc, int fr, int fq) const {
        const int row0 = u.pm * BM + wr * 64 + fr; const int colw = u.pn * BM + wc * 32; const int col0 = colw + 8 * fq;
#pragma unroll
        for (int bj = 0; bj < 2; ++bj) {
            bool rope = false; int pair0 = 0;
            if (ROPE) { const int sec = (colw + bj * HALF) % rope_period; rope = (sec >= rope_start) && (sec < rope_start + 64); pair0 = ((sec - rope_start) >> 1) + 4 * fq; }
#pragma unroll
            for (int ai = 0; ai < 2; ++ai)
#pragma unroll
                for (int m = 0; m < 4; ++m) {
                    const int row = row0 + ai * HALF + m * 16;
                    const float rsc = rs[wr * 64 + fr + ai * HALF + m * 16];
                    f32x4 v0 = acc[ai][bj][m][0] * rsc, v1 = acc[ai][bj][m][1] * rsc;
                    if (ACT == 2) {
#pragma unroll
                        for (int e = 0; e < 4; ++e) { const float a = fmaxf(v0[e], 0.f), b = fmaxf(v1[e], 0.f); v0[e] = a * a; v1[e] = b * b; }
                    }
                    if (ROPE) { if (rope) {
                        const float* tp = rope_tab + ((size_t)(row & 8191) * 32 + pair0) * 2;
                        const f32x4 t0 = *(const f32x4*)tp, t1 = *(const f32x4*)(tp + 4);
                        f32x4 r0, r1;
                        r0[0] = v0[0] * t0[0] - v0[1] * t0[1]; r0[1] = v0[1] * t0[0] + v0[0] * t0[1];
                        r0[2] = v0[2] * t0[2] - v0[3] * t0[3]; r0[3] = v0[3] * t0[2] + v0[2] * t0[3];
                        r1[0] = v1[0] * t1[0] - v1[1] * t1[1]; r1[1] = v1[1] * t1[0] + v1[0] * t1[1];
                        r1[2] = v1[2] * t1[2] - v1[3] * t1[3]; r1[3] = v1[3] * t1[2] + v1[2] * t1[3];
                        v0 = r0; v1 = r1; } }
                    u32x4 w; w.x = cvt_pk_bf16(v0[0], v0[1]); w.y = cvt_pk_bf16(v0[2], v0[3]); w.z = cvt_pk_bf16(v1[0], v1[1]); w.w = cvt_pk_bf16(v1[2], v1[3]);
                    *(u32x4*)(O + (size_t)row * ldc + col0 + bj * HALF) = w;
                }
        }
    }
};
struct EpiRes {
    static constexpr bool PERM = true, AFTER_DRAIN = false;
    bf16_t* xb; float* part; int ldc;
    __device__ __forceinline__ void operator()(const f32x4 (&acc)[2][2][4][2], const Unit& u, int wr, int wc, int fr, int fq) const {
        const int col0 = u.pn * BM + wc * 32 + 8 * fq;
#pragma unroll
        for (int ai = 0; ai < 2; ++ai)
#pragma unroll
            for (int m = 0; m < 4; ++m) { const int row = u.pm * BM + ai * HALF + wr * 64 + m * 16 + fr; const size_t off = (size_t)row * ldc + col0;
                u32x4 bs[2];
#pragma unroll
                for (int bj = 0; bj < 2; ++bj) bs[bj] = *(const u32x4*)(xb + off + bj * HALF);
                float ss = 0.f;
#pragma unroll
                for (int bj = 0; bj < 2; ++bj) { const u32x4 b = bs[bj]; const f32x4 a0 = acc[ai][bj][m][0], a1 = acc[ai][bj][m][1];
                    const float o0 = __uint_as_float(b.x << 16) + a0[0], o1 = __uint_as_float(b.x & 0xffff0000u) + a0[1], o2 = __uint_as_float(b.y << 16) + a0[2], o3 = __uint_as_float(b.y & 0xffff0000u) + a0[3];
                    const float o4 = __uint_as_float(b.z << 16) + a1[0], o5 = __uint_as_float(b.z & 0xffff0000u) + a1[1], o6 = __uint_as_float(b.w << 16) + a1[2], o7 = __uint_as_float(b.w & 0xffff0000u) + a1[3];
                    ss += ((o0 * o0 + o1 * o1) + (o2 * o2 + o3 * o3)) + ((o4 * o4 + o5 * o5) + (o6 * o6 + o7 * o7));
                    u32x4 w; w.x = cvt_pk_bf16(o0, o1); w.y = cvt_pk_bf16(o2, o3); w.z = cvt_pk_bf16(o4, o5); w.w = cvt_pk_bf16(o6, o7);
                    *(u32x4*)(xb + off + bj * HALF) = w; }
                ss += __shfl_xor(ss, 16); ss += __shfl_xor(ss, 32);
                if (fq == 0) part[(size_t)row * 32 + u.pn * 4 + wc] = ss;
            }
    }
};
template <class Epi, class Sched, bool ALIGN_EPI = false, bool SP2 = false>
__device__ __forceinline__ void gemm_phase(PG8_LAS unsigned char* lds, const Gemm g, const Sched& S, const Epi& E) {
    int tid_ = threadIdx.x; asm volatile("" : "+v"(tid_));
    const int tid = tid_, wid = __builtin_amdgcn_readfirstlane(tid >> 6), lane = tid & 63, wr = wid >> 2, wc = wid & 3, fr = lane & 15, fq = lane >> 4;
    int K_ = g.K, lda_ = g.lda; asm volatile("" : "+s"(K_), "+s"(lda_));
    const int K = K_, nt = K / BK, LDA = lda_;
    unsigned voffA[2], voffB[2];
#pragma unroll
    for (int i = 0; i < 2; ++i) { int R, C; stage_rc(tid * 16 + i * 8192, R, C); const int Rb = Epi::PERM ? ((R & ~31) + perm32(R & 31)) : R;
        voffA[i] = (unsigned)(R * LDA + C) * 2u; voffB[i] = (unsigned)(Rb * K + C) * 2u; }
    const size_t kstep = (size_t)(BK * 2);
    const size_t hstep = (size_t)HALF * K * 2;
    const size_t tstep = 2 * hstep; const size_t hstepA = (size_t)HALF * LDA * 2, tstepA = 2 * hstepA;
    const unsigned ldsw = (unsigned)wid * 1024u;
    const int aoff = lds_byte(wr * 64 + fr, fq * 8), boff = lds_byte(wc * 32 + fr, fq * 8);
#define PG8_SA(b, h) (((b) * 2 + (h)) * HTB)
#define PG8_SB(b, h) ((4 + (b) * 2 + (h)) * HTB)
#define PG8_STAGE(bufoff, gbase, voff) do { _Pragma("unroll") for (int _i = 0; _i < 2; ++_i) \
        __builtin_amdgcn_global_load_lds((const unsigned*)((const char*)(gbase) + (voff)[_i]), (PG8_LAS unsigned*)(lds + (bufoff) + ldsw + _i * 8192), 16, 0, 0); } while (0)
#define PG8_LDA(dst, b, h) do { _Pragma("unroll") for (int m = 0; m < 4; ++m) _Pragma("unroll") for (int k = 0; k < 2; ++k) dst[m][k] = *(const PG8_LAS bf16x8*)(lds + PG8_SA(b, h) + aoff + m * 2048 + k * 1024); } while (0)
#define PG8_LDB(dst, b, h) do { _Pragma("unroll") for (int n = 0; n < 2; ++n) _Pragma("unroll") for (int k = 0; k < 2; ++k) dst[n][k] = *(const PG8_LAS bf16x8*)(lds + PG8_SB(b, h) + boff + n * 2048 + k * 1024); } while (0)
#define PG8_MMA(ai, bj, At, Bt) do { __builtin_amdgcn_s_setprio(1); _Pragma("unroll") for (int m = 0; m < 4; ++m) _Pragma("unroll") for (int n = 0; n < 2; ++n) _Pragma("unroll") for (int k = 0; k < 2; ++k) \
        acc[ai][bj][m][n] = __builtin_amdgcn_mfma_f32_16x16x32_bf16(Bt[n][k], At[m][k], acc[ai][bj][m][n], 0, 0, 0); __builtin_amdgcn_s_setprio(0); } while (0)
#define PG8_WAIT_V(n) asm volatile("s_waitcnt vmcnt(" #n ")" ::: "memory")
#define PG8_WAIT_L(n) asm volatile("s_waitcnt lgkmcnt(" #n ")" ::: "memory")
#define PG8_BAR __builtin_amdgcn_s_barrier()
#define PG8_SCHED __builtin_amdgcn_sched_barrier(0)
    Unit cur, nxt; int ui = 0;
    if (!S.next(0, cur)) return;
    f32x4 acc[2][2][4][2];
#pragma unroll
    for (int a = 0; a < 2; ++a)
#pragma unroll
        for (int b = 0; b < 2; ++b)
#pragma unroll
            for (int m = 0; m < 4; ++m)
#pragma unroll
                for (int n = 0; n < 2; ++n) acc[a][b][m][n] = (f32x4){0.f, 0.f, 0.f, 0.f};
    bf16x8 At[4][2], B0[2][2], B1[2][2];
    const char* cA = (const char*)g.A + (size_t)cur.pm * tstepA; const char* cB = (const char*)g.Bt + (size_t)cur.pn * tstep;
    S.a_ready(cur);
    if constexpr (SP2) {
        PG8_STAGE(PG8_SB(0, 0), cB, voffB); PG8_STAGE(PG8_SB(0, 1), cB + hstep, voffB); PG8_STAGE(PG8_SA(0, 0), cA, voffA); PG8_STAGE(PG8_SA(0, 1), cA + hstepA, voffA);
        if (wr == 1) PG8_BAR;
        PG8_WAIT_V(2); PG8_BAR;
        PG8_STAGE(PG8_SB(1, 0), cB + kstep, voffB); PG8_STAGE(PG8_SA(1, 0), cA + kstep, voffA); PG8_STAGE(PG8_SB(1, 1), cB + hstep + kstep, voffB);
        PG8_WAIT_V(6); PG8_BAR;
    } else {
        PG8_STAGE(PG8_SB(0, 0), cB, voffB); PG8_STAGE(PG8_SA(0, 0), cA, voffA); PG8_STAGE(PG8_SB(0, 1), cB + hstep, voffB); PG8_STAGE(PG8_SA(0, 1), cA + hstepA, voffA);
        if (wr == 1) PG8_BAR;
        PG8_WAIT_V(4); PG8_BAR;
        PG8_STAGE(PG8_SB(1, 0), cB + kstep, voffB); PG8_STAGE(PG8_SA(1, 0), cA + kstep, voffA); PG8_STAGE(PG8_SB(1, 1), cB + hstep + kstep, voffB);
        PG8_WAIT_V(6); PG8_BAR;
    }
    for (;;) {
        const bool has_next = S.next(ui + 1, nxt);
        const char* nA = has_next ? (const char*)g.A + (size_t)nxt.pm * tstepA : cA; const char* nB = has_next ? (const char*)g.Bt + (size_t)nxt.pn * tstep : cB;
        for (int t = 0; t < nt; t += 2) {
            const bool last = (t == nt - 2);
            const char* a1 = cA + (size_t)(t + 1) * kstep;
            const char* a2 = last ? nA : cA + (size_t)(t + 2) * kstep; const char* b2 = last ? nB : cB + (size_t)(t + 2) * kstep;
            const char* a3 = a2 + kstep; const char* b3 = b2 + kstep;
            if (last && has_next) S.a_ready(nxt);
            if constexpr (SP2) {
            PG8_LDB(B0, 0, 0); PG8_LDB(B1, 0, 1); PG8_SCHED; PG8_LDA(At, 0, 0); PG8_STAGE(PG8_SA(1, 1), a1 + hstepA, voffA);
            PG8_WAIT_V(8); PG8_WAIT_L(0); PG8_BAR; PG8_MMA(0, 0, At, B0); PG8_MMA(0, 1, At, B1); PG8_BAR; PG8_SCHED;
            PG8_LDA(At, 0, 1); PG8_STAGE(PG8_SB(0, 0), b2, voffB); PG8_STAGE(PG8_SB(0, 1), b2 + hstep, voffB); PG8_STAGE(PG8_SA(0, 0), a2, voffA);
            PG8_WAIT_V(8); PG8_WAIT_L(0); PG8_BAR; PG8_MMA(1, 0, At, B0); PG8_MMA(1, 1, At, B1); PG8_BAR; PG8_SCHED;
            PG8_LDB(B0, 1, 0); PG8_LDB(B1, 1, 1); PG8_SCHED; PG8_LDA(At, 1, 0); PG8_STAGE(PG8_SA(0, 1), a2 + hstepA, voffA);
            PG8_WAIT_V(8); PG8_WAIT_L(0); PG8_BAR; PG8_MMA(0, 0, At, B0); PG8_MMA(0, 1, At, B1); PG8_BAR; PG8_SCHED;
            PG8_LDA(At, 1, 1); PG8_STAGE(PG8_SB(1, 0), b3, voffB); PG8_STAGE(PG8_SB(1, 1), b3 + hstep, voffB); PG8_STAGE(PG8_SA(1, 0), a3, voffA);
            PG8_WAIT_V(8); PG8_WAIT_L(0); PG8_BAR; PG8_MMA(1, 0, At, B0); PG8_MMA(1, 1, At, B1); PG8_BAR; PG8_SCHED;
            } else {
            PG8_LDB(B0, 0, 0); PG8_SCHED; PG8_LDA(At, 0, 0); PG8_STAGE(PG8_SA(1, 1), a1 + hstepA, voffA);
            PG8_WAIT_L(8); PG8_BAR; PG8_WAIT_L(0); PG8_MMA(0, 0, At, B0); PG8_BAR; PG8_SCHED;
            PG8_LDB(B1, 0, 1); PG8_STAGE(PG8_SB(0, 0), b2, voffB);
            PG8_BAR; PG8_WAIT_L(0); PG8_MMA(0, 1, At, B1); PG8_BAR;
            PG8_LDA(At, 0, 1); PG8_STAGE(PG8_SA(0, 0), a2, voffA);
            PG8_BAR; PG8_WAIT_L(0); PG8_MMA(1, 0, At, B0); PG8_BAR; PG8_SCHED;
            PG8_STAGE(PG8_SB(0, 1), b2 + hstep, voffB);
            PG8_WAIT_V(6); PG8_BAR; PG8_MMA(1, 1, At, B1); PG8_BAR;
            PG8_LDB(B0, 1, 0); PG8_SCHED; PG8_LDA(At, 1, 0); PG8_STAGE(PG8_SA(0, 1), a2 + hstepA, voffA);
            PG8_WAIT_L(8); PG8_BAR; PG8_WAIT_L(0); PG8_MMA(0, 0, At, B0); PG8_BAR; PG8_SCHED;
            PG8_LDB(B1, 1, 1); PG8_STAGE(PG8_SB(1, 0), b3, voffB);
            PG8_BAR; PG8_WAIT_L(0); PG8_MMA(0, 1, At, B1); PG8_BAR;
            PG8_LDA(At, 1, 1); PG8_STAGE(PG8_SA(1, 0), a3, voffA);
            PG8_BAR; PG8_WAIT_L(0); PG8_MMA(1, 0, At, B0); PG8_BAR; PG8_SCHED;
            PG8_STAGE(PG8_SB(1, 1), b3 + hstep, voffB);
            PG8_WAIT_V(6); PG8_BAR; PG8_MMA(1, 1, At, B1); PG8_BAR;
            }
        }
        if constexpr (ALIGN_EPI) { if (wr == 0) PG8_BAR; }
        if constexpr (!Epi::AFTER_DRAIN) { E(acc, cur, wr, wc, fr, fq); S.done(cur); }
        if (!has_next) break;
#pragma unroll
        for (int a = 0; a < 2; ++a)
#pragma unroll
            for (int b = 0; b < 2; ++b)
#pragma unroll
                for (int m = 0; m < 4; ++m)
#pragma unroll
                    for (int n = 0; n < 2; ++n) acc[a][b][m][n] = (f32x4){0.f, 0.f, 0.f, 0.f};
        cur = nxt; cA = nA; cB = nB; ++ui;
        if constexpr (ALIGN_EPI) { if (wr == 1) PG8_BAR; }
    }
    PG8_WAIT_V(0);
    if constexpr (!ALIGN_EPI) { if (wr == 0) PG8_BAR; }
    PG8_BAR;
    if constexpr (Epi::AFTER_DRAIN) { E.fused(acc, cur, wr, wc, fr, fq, lds, wid, lane); S.done(cur); }
#undef PG8_SA
#undef PG8_SB
#undef PG8_STAGE
#undef PG8_LDA
#undef PG8_LDB
#undef PG8_MMA
#undef PG8_WAIT_V
#undef PG8_WAIT_L
#undef PG8_BAR
#undef PG8_SCHED
}
}
#define LAS __attribute__((address_space(3)))
typedef unsigned short bf16;
typedef float f32x4 __attribute__((ext_vector_type(4)));
typedef unsigned u32x4 __attribute__((ext_vector_type(4)));
typedef unsigned u32x2 __attribute__((ext_vector_type(2)));
constexpr int BATCH = 2, SEQ = 8192, DM = 2048, M = BATCH * SEQ, DEPTH = 2;
constexpr int NIN = 3648, NINP = 3840, QR = 384, KVR = 128, NQ = 1536, NKV = 2048, DFF = 8192;
constexpr int C_KROPE = 512, C_QB = 576, C_KB = 1088, C_VB = 1600, C_QC = 2112, C_KC = 2624, C_VC = 3136;
constexpr float EPS = 1e-6f, LOG2E = 1.4426950408889634f;
constexpr size_t MiB = 1u << 20;
constexpr size_t WS_CTL = 0, WS_ROPE = 1 * MiB, WS_PART = 4 * MiB, WS_W = 6 * MiB, W_LAYER = 90 * MiB;
constexpr size_t WO_IN = 0, WO_UQ = 15 * MiB, WO_UKV = 17 * MiB, WO_O = 18 * MiB, WO_UP = 26 * MiB, WO_DN = 58 * MiB;
constexpr size_t WS_XB = 186 * MiB, WS_HN = 250 * MiB, WS_QA = 314 * MiB, WS_KVA = 362 * MiB, WS_HFF = 250 * MiB, WS_END = 506 * MiB;
static_assert((size_t)NINP * DM * 2 <= 15 * MiB && (size_t)NQ * QR * 2 <= 2 * MiB && (size_t)M * NINP * 2 <= 120 * MiB && (size_t)M * NQ * 2 <= 48 * MiB && (size_t)M * DFF * 2 <= 256 * MiB, "ws map");
constexpr int CW_BAR = 4096;
constexpr int LDS_BYTES = 147456, MISC_OFF = 131072;
constexpr int NTHREADS = 512, NWAVES = 8;

typedef float f32x2_t __attribute__((ext_vector_type(2))); typedef __bf16 bf16x2_t __attribute__((ext_vector_type(2)));
__device__ __forceinline__ unsigned cvtpk(float lo, float hi) { f32x2_t v = {lo, hi}; bf16x2_t b = __builtin_convertvector(v, bf16x2_t); return __builtin_bit_cast(unsigned, b); }
__device__ __forceinline__ float wave_sum(float v) {
#pragma unroll
    for (int o = 1; o < 64; o <<= 1) v += __shfl_xor(v, o);
    return v;
}
#define LDS_WAIT() asm volatile("s_waitcnt lgkmcnt(0)" ::: "memory")

__device__ __forceinline__ int dstmap(int mode, int n) {
    if (mode == 1) { if (n >= 512 && n < 576) { const int i = n - 512; return 512 + (i < 32 ? 2 * i : 2 * (i - 32) + 1); } return n; }
    if (mode == 2) { const int hh = n / 192; int r = n - hh * 192; if (r >= 128) { const int i = r - 128; r = 128 + (i < 32 ? 2 * i : 2 * (i - 32) + 1); } return hh * 192 + r; }
    return n;
}
__device__ __forceinline__ void transpose_item(const float* __restrict__ W, int K, int N, const float* __restrict__ g, bf16* __restrict__ WT, int mode, LAS float* scr, int item, int lane) {
    const int nblk = N / 32, kb = item / nblk, nb = item - kb * nblk, k0 = 64 * kb, n0 = 32 * nb;
    f32x4 v[8]; const int kr = lane >> 3, n4 = (lane & 7) * 4;
#pragma unroll
    for (int i = 0; i < 8; ++i) v[i] = *(const f32x4*)(W + (size_t)(k0 + 8 * i + kr) * N + n0 + n4);
#pragma unroll
    for (int i = 0; i < 8; ++i) { const int kk = 8 * i + kr; const float gg = g ? g[k0 + kk] : 1.0f;
        scr[kk * 33 + n4 + 0] = v[i].x * gg; scr[kk * 33 + n4 + 1] = v[i].y * gg; scr[kk * 33 + n4 + 2] = v[i].z * gg; scr[kk * 33 + n4 + 3] = v[i].w * gg; }
    LDS_WAIT(); asm volatile("" ::: "memory");
    const int c = lane & 7;
#pragma unroll
    for (int j = 0; j < 4; ++j) { const int n = (lane >> 3) + 8 * j; const LAS float* s = scr + (8 * c) * 33 + n;
        u32x4 o; o.x = cvtpk(s[0 * 33], s[1 * 33]); o.y = cvtpk(s[2 * 33], s[3 * 33]); o.z = cvtpk(s[4 * 33], s[5 * 33]); o.w = cvtpk(s[6 * 33], s[7 * 33]);
        *(u32x4*)(WT + (size_t)dstmap(mode, n0 + n) * K + k0 + 8 * c) = o; }
    LDS_WAIT(); asm volatile("" ::: "memory");
}
__device__ __forceinline__ void xb_rows_phase(const float* __restrict__ x, bf16* __restrict__ xb, float* __restrict__ part, int gw, int ngw, int lane) {
    for (int mrow = gw; mrow < M; mrow += ngw) {
        const f32x4* xr = (const f32x4*)(x + (size_t)mrow * DM) + 2 * lane;
        f32x4 v[8]; float s = 0.f;
#pragma unroll
        for (int j = 0; j < 4; ++j) { v[2 * j] = xr[128 * j]; v[2 * j + 1] = xr[128 * j + 1]; }
#pragma unroll
        for (int j = 0; j < 8; ++j) s += (v[j].x * v[j].x + v[j].y * v[j].y) + (v[j].z * v[j].z + v[j].w * v[j].w);
        s = wave_sum(s);
        u32x4* o16 = (u32x4*)(xb + (size_t)mrow * DM) + lane;
#pragma unroll
        for (int j = 0; j < 4; ++j) { u32x4 w; w.x = cvtpk(v[2 * j].x, v[2 * j].y); w.y = cvtpk(v[2 * j].z, v[2 * j].w); w.z = cvtpk(v[2 * j + 1].x, v[2 * j + 1].y); w.w = cvtpk(v[2 * j + 1].z, v[2 * j + 1].w); o16[64 * j] = w; }
        if (lane < 32) part[(size_t)mrow * 32 + lane] = lane == 0 ? s : 0.f;
    }
}
__device__ __forceinline__ void panel_rstd_from_part(const float* __restrict__ part, int pm, LAS float* rs, int tid) {
    const int row = tid >> 1, half = tid & 1;
    const f32x4* p = (const f32x4*)(part + ((size_t)pm * 256 + row) * 32 + half * 16);
    const f32x4 a = p[0], b = p[1], c = p[2], d = p[3];
    float sm = ((a.x + a.y) + (a.z + a.w)) + ((b.x + b.y) + (b.z + b.w)) + ((c.x + c.y) + (c.z + c.w)) + ((d.x + d.y) + (d.z + d.w));
    sm += __shfl_xor(sm, 1);
    if (half == 0) rs[row] = 1.0f / sqrtf(sm * (1.f / DM) + EPS);
    __syncthreads();
}
__device__ __forceinline__ void panel_rstd_cqkv(const bf16* __restrict__ proj, int pm, LAS float* rq, LAS float* rkv, int wave, int lane) {
#pragma unroll 4
    for (int i = 0; i < 32; ++i) { const int row = wave * 32 + i;
        const u32x4 w = *((const u32x4*)(proj + ((size_t)pm * 256 + row) * NINP) + lane);
        float sq = 0.f;
#pragma unroll
        for (int e = 0; e < 4; ++e) { const float f0 = __uint_as_float(w[e] << 16), f1 = __uint_as_float(w[e] & 0xffff0000u); sq += f0 * f0 + f1 * f1; }
        const float tq = wave_sum(lane < 48 ? sq : 0.f), tkv = wave_sum(lane < 48 ? 0.f : sq);
        if (lane == 0) { rq[row] = 1.0f / sqrtf(tq * (1.f / QR) + EPS); rkv[row] = 1.0f / sqrtf(tkv * (1.f / KVR) + EPS); } }
    __syncthreads();
}
__device__ __forceinline__ void final_norm_phase(const bf16* __restrict__ xb, float* __restrict__ out, const float* __restrict__ g, int gw, int ngw, int lane) {
    for (int mrow = gw; mrow < M; mrow += ngw) {
        const u32x4* xr = (const u32x4*)(xb + (size_t)mrow * DM) + lane; const f32x4* gr = (const f32x4*)g + 2 * lane;
        f32x4 v[8]; float s = 0.f;
#pragma unroll
        for (int j = 0; j < 4; ++j) { const u32x4 w = xr[64 * j];
            v[2 * j] = (f32x4){__uint_as_float(w.x << 16), __uint_as_float(w.x & 0xffff0000u), __uint_as_float(w.y << 16), __uint_as_float(w.y & 0xffff0000u)};
            v[2 * j + 1] = (f32x4){__uint_as_float(w.z << 16), __uint_as_float(w.z & 0xffff0000u), __uint_as_float(w.w << 16), __uint_as_float(w.w & 0xffff0000u)}; }
#pragma unroll
        for (int j = 0; j < 8; ++j) s += (v[j].x * v[j].x + v[j].y * v[j].y) + (v[j].z * v[j].z + v[j].w * v[j].w);
        const float rstd = 1.0f / sqrtf(wave_sum(s) * (1.f / DM) + EPS);
        f32x4* orow = (f32x4*)(out + (size_t)mrow * DM) + 2 * lane;
#pragma unroll
        for (int j = 0; j < 4; ++j) { orow[128 * j] = v[2 * j] * rstd * gr[128 * j]; orow[128 * j + 1] = v[2 * j + 1] * rstd * gr[128 * j + 1]; }
    }
}
__device__ __forceinline__ const float* arg_in(int i) { asm volatile("" : "+s"(i)); return ((const float* const __attribute__((address_space(4)))*)__builtin_amdgcn_kernarg_segment_ptr())[i]; }
constexpr int I_IN = (DM / 64) * (NIN / 32), I_UQ = (QR / 64) * (NQ / 32), I_UKV = (KVR / 64) * (NKV / 32), I_O = (DM / 64) * (DM / 32), I_UP = (DM / 64) * (DFF / 32), I_DN = (DFF / 64) * (DM / 32);
constexpr int I_LAYER = I_IN + I_UQ + I_UKV + I_O + I_UP + I_DN;
__device__ __forceinline__ unsigned char* arg_ws() { int o = 19; asm volatile("" : "+s"(o)); return ((unsigned char* const __attribute__((address_space(4)))*)__builtin_amdgcn_kernarg_segment_ptr())[o]; }
constexpr int I_EARLY = I_IN + I_UQ + I_UKV;
constexpr int N_DEFER = (I_LAYER - I_EARLY) + (DEPTH - 1) * I_LAYER;
constexpr int CONV_CHUNK = 64, N_CONV_CHUNKS = (N_DEFER + CONV_CHUNK - 1) / CONV_CHUNK;
__device__ __forceinline__ void convert_item(int l, int r, unsigned char* ws, LAS float* scr, int lane) {
    unsigned char* wl = ws + WS_W + (size_t)l * W_LAYER;
    if (r < I_IN) { transpose_item(arg_in(2) + (size_t)l * DM * NIN, DM, NIN, arg_in(1) + l * DM, (bf16*)(wl + WO_IN), 1, scr, r, lane); return; } r -= I_IN;
    if (r < I_UQ) { transpose_item(arg_in(5) + (size_t)l * QR * NQ, QR, NQ, arg_in(3) + l * QR, (bf16*)(wl + WO_UQ), 2, scr, r, lane); return; } r -= I_UQ;
    if (r < I_UKV) { transpose_item(arg_in(6) + (size_t)l * KVR * NKV, KVR, NKV, arg_in(4) + l * KVR, (bf16*)(wl + WO_UKV), 0, scr, r, lane); return; } r -= I_UKV;
    if (r < I_O) { transpose_item(arg_in(13) + (size_t)l * DM * DM, DM, DM, nullptr, (bf16*)(wl + WO_O), 0, scr, r, lane); return; } r -= I_O;
    if (r < I_UP) { transpose_item(arg_in(15) + (size_t)l * DM * DFF, DM, DFF, arg_in(14) + l * DM, (bf16*)(wl + WO_UP), 0, scr, r, lane); return; } r -= I_UP;
    transpose_item(arg_in(16) + (size_t)l * DFF * DM, DFF, DM, nullptr, (bf16*)(wl + WO_DN), 0, scr, r, lane);
}
namespace att {
typedef short bf16x8 __attribute__((ext_vector_type(8)));
typedef short s16x4 __attribute__((ext_vector_type(4)));
typedef short v4i16_t __attribute__((ext_vector_type(4)));
typedef float f32x16 __attribute__((ext_vector_type(16)));
constexpr int VS = 320, VBYTES = 64 * VS, KMAXB = 64 * (192 * 2 + 16);
constexpr int V_OFF0 = 0, V_OFF1 = VBYTES, K_OFF0 = 2 * VBYTES;
constexpr int QPARK_OFF = K_OFF0 + 2 * KMAXB;
constexpr int STASH_OFF = K_OFF0 + 2 * 64 * (64 * 2 + 16);
static_assert(QPARK_OFF + 8 * 4096 <= MISC_OFF && STASH_OFF + 65536 <= MISC_OFF, "attention LDS");
__device__ __forceinline__ s16x4 vtr(const LAS unsigned char* p) { return __builtin_bit_cast(s16x4, __builtin_amdgcn_ds_read_tr16_b64_v4i16((LAS v4i16_t*)p)); }
#define MFMA32(a, b, c) __builtin_amdgcn_mfma_f32_32x32x16_bf16((a), (b), (c), 0, 0, 0)

template <int DQK, int BIAS, bool AHEAD = true>
__device__ __forceinline__ void flash_loop(LAS unsigned char* lds, const bf16* __restrict__ Qrow,
        const bf16* __restrict__ Ka, int kap, const bf16* __restrict__ Kb, int kbp, const bf16* __restrict__ Vp, int vpp,
        int t_lo, int t_hi, int wt_lo, int wt_hi, float c, float slope2, const LAS float* tab, int qpos,
        f32x16 (&o)[4], float& m_io, float& l_io, const float* __restrict__ kn2row = nullptr, int q0blk = 0) {
    int tid_ = threadIdx.x; asm volatile("" : "+v"(tid_));
    const int tid = tid_, lane = tid & 63, hi = lane >> 5, l32 = lane & 31;
    constexpr int KS = DQK * 2 + 16, CPR = DQK / 8, NKC = DQK / 64, NDS = DQK / 16;
    constexpr int NQR = (DQK == 192 && AHEAD) ? 8 : NDS;
    bf16x8 qf[NQR];
#pragma unroll
    for (int ds = 0; ds < NQR; ++ds) qf[ds] = *(const bf16x8*)(Qrow + 16 * ds + 8 * hi);
    LAS unsigned char* qpark = lds + QPARK_OFF + (tid >> 6) * 4096 + lane * 16;
#pragma unroll
    for (int ds = NQR; ds < NDS; ++ds) *(LAS bf16x8*)(qpark + (ds - NQR) * 1024) = *(const bf16x8*)(Qrow + 16 * ds + 8 * hi);
    constexpr int K_OFF1 = K_OFF0 + 64 * KS;
    LAS float* red = (LAS float*)(lds + MISC_OFF + 1600);
    if (BIAS == 1) {
        float qn2 = 0.f;
#pragma unroll
        for (int ds = 0; ds < NQR; ++ds)
#pragma unroll
            for (int e = 0; e < 8; ++e) { const float v = __uint_as_float(((unsigned)(unsigned short)qf[ds][e]) << 16); qn2 += v * v; }
        qn2 += __shfl_xor(qn2, 32);
#pragma unroll
        for (int sh = 1; sh < 32; sh <<= 1) qn2 = fmaxf(qn2, __shfl_xor(qn2, sh));
        if (lane == 0) red[tid >> 6] = qn2;
    }
    int tlo = t_lo;
    const int t_dec = (BIAS == 1 && kn2row != nullptr && t_hi - 4 > t_lo + 1) ? t_hi - 4 : -1;
    unsigned koffB[NKC]; int kdst[NKC];
#pragma unroll
    for (int i = 0; i < NKC; ++i) {
        if (DQK == 64) { const int row = tid >> 3, ch = tid & 7; koffB[i] = (unsigned)(row * kap + ch * 8) * 2u; kdst[i] = row * KS + ch * 16; }
        else if (DQK == 192 && i == 2) { const int row = tid >> 3, ch = tid & 7; koffB[i] = (unsigned)(row * kbp + ch * 8) * 2u; kdst[i] = row * KS + (16 + ch) * 16; }
        else { const int cidx = tid + NTHREADS * i, row = cidx >> 4, ch = cidx & 15; koffB[i] = (unsigned)(row * kap + ch * 8) * 2u; kdst[i] = row * KS + ch * 16; } }
    unsigned voffB[2]; int vdst[2];
#pragma unroll
    for (int i = 0; i < 2; ++i) { const int cidx = tid + NTHREADS * i, row = cidx >> 4, ch = cidx & 15; voffB[i] = (unsigned)(row * vpp + ch * 8) * 2u; vdst[i] = row * VS + ch * 16; }
    u32x4 kreg[NKC], vreg[2];
    float m = m_io, l = l_io;
    const int koffL = l32 * KS + hi * 16;
    const int i16 = lane & 15, tq = i16 >> 2, tp = i16 & 3, blk = (lane >> 4) & 1;
    const int voffL = (4 * hi + tq) * VS + (16 * blk + 4 * tp) * 2;
    f32x16 sc0, sc1, sn0, sn1;
#define ATT_KLD(dst0, dst1, ds_) do { if ((ds_) < NDS) { dst0 = *(const LAS bf16x8*)(kq_ + (ds_) * 32); dst1 = *(const LAS bf16x8*)(kq_ + 32 * KS + (ds_) * 32); } } while (0)
#define ATT_QLD(ds_) ((ds_) < NQR ? qf[(ds_) < NQR ? (ds_) : 0] : *(const LAS bf16x8*)(qpark + ((ds_) - NQR) * 1024))
#define ATT_QK(S0, S1, kb_) do { const LAS unsigned char* kq_ = lds + ((kb_) ? K_OFF1 : K_OFF0) + koffL; \
        bf16x8 ka_[4][2]; \
        ATT_KLD(ka_[0][0], ka_[0][1], 0); ATT_KLD(ka_[1][0], ka_[1][1], 1); ATT_KLD(ka_[2][0], ka_[2][1], 2); \
        __builtin_amdgcn_s_setprio(1); \
        _Pragma("unroll") for (int r_ = 0; r_ < 16; ++r_) { S0[r_] = 0.f; S1[r_] = 0.f; } \
        _Pragma("unroll") for (int ds_ = 0; ds_ < NDS; ++ds_) { \
            ATT_KLD(ka_[(ds_ + 3) & 3][0], ka_[(ds_ + 3) & 3][1], ds_ + 3); \
            const bf16x8 q_ = ATT_QLD(ds_); \
            S0 = MFMA32(ka_[ds_ & 3][0], q_, S0); S1 = MFMA32(ka_[ds_ & 3][1], q_, S1); \
            __builtin_amdgcn_sched_barrier(0); } __builtin_amdgcn_s_setprio(0); } while (0)
#define ATT_SMPV(S0, S1, tt_) do { \
        const int dq_ = qpos - 64 * (tt_) - 4 * hi; \
        _Pragma("unroll") for (int r_ = 0; r_ < 16; ++r_) { const int kr_ = (r_ & 3) + 8 * (r_ >> 2); \
            if (BIAS == 0) { }   \
            else if (BIAS == 1) { const float fd_ = (float)dq_; S0[r_] = S0[r_] * c - slope2 * fabsf(fd_ - (float)kr_); S1[r_] = S1[r_] * c - slope2 * fabsf(fd_ - (float)(kr_ + 32)); } \
            else { const int d0_ = dq_ - kr_; const int i0_ = min(max(d0_, -63), 256) + 63, i1_ = min(max(d0_ - 32, -63), 256) + 63; S0[r_] = S0[r_] * c + tab[i0_]; S1[r_] = S1[r_] * c + tab[i1_]; } } \
        float mx_ = fmaxf(S0[0], S1[0]); \
        _Pragma("unroll") for (int r_ = 1; r_ < 16; ++r_) mx_ = fmaxf(mx_, fmaxf(S0[r_], S1[r_])); \
        mx_ = fmaxf(mx_, __shfl_xor(mx_, 32)); \
        if (BIAS == 0) mx_ *= c; \
        const float mn_ = fmaxf(m, mx_), alpha_ = __builtin_amdgcn_exp2f(m - mn_); m = mn_; \
        float ps_ = 0.f; \
        _Pragma("unroll") for (int r_ = 0; r_ < 16; ++r_) { \
            if (BIAS == 0) { S0[r_] = __builtin_amdgcn_exp2f(__builtin_fmaf(S0[r_], c, -mn_)); S1[r_] = __builtin_amdgcn_exp2f(__builtin_fmaf(S1[r_], c, -mn_)); } \
            else { S0[r_] = __builtin_amdgcn_exp2f(S0[r_] - mn_); S1[r_] = __builtin_amdgcn_exp2f(S1[r_] - mn_); } \
            ps_ += S0[r_] + S1[r_]; } \
        l = l * alpha_ + ps_; \
        if (__any(alpha_ != 1.f)) { _Pragma("unroll") for (int d_ = 0; d_ < 4; ++d_) _Pragma("unroll") for (int r_ = 0; r_ < 16; ++r_) o[d_][r_] *= alpha_; } \
        u32x4 pw_[4]; \
        _Pragma("unroll") for (int e_ = 0; e_ < 4; ++e_) { pw_[0][e_] = cvtpk(S0[2 * e_], S0[2 * e_ + 1]); pw_[1][e_] = cvtpk(S0[8 + 2 * e_], S0[8 + 2 * e_ + 1]); \
                                                          pw_[2][e_] = cvtpk(S1[2 * e_], S1[2 * e_ + 1]); pw_[3][e_] = cvtpk(S1[8 + 2 * e_], S1[8 + 2 * e_ + 1]); } \
        const LAS unsigned char* vb_ = lds + (((tt_) & 1) ? V_OFF1 : V_OFF0) + voffL; \
        s16x4 vl_[4], vh_[4]; \
        _Pragma("unroll") for (int i_ = 0; i_ < 3; ++i_) { vl_[i_] = vtr(vb_ + i_ * 64); vh_[i_] = vtr(vb_ + 8 * VS + i_ * 64); } \
        _Pragma("unroll") for (int i_ = 0; i_ < 16; ++i_) { const int st_ = i_ >> 2, d_ = i_ & 3; \
            if (i_ + 3 < 16) { const int s2_ = (i_ + 3) >> 2, d2_ = (i_ + 3) & 3; vl_[(i_ + 3) & 3] = vtr(vb_ + (16 * s2_) * VS + d2_ * 64); vh_[(i_ + 3) & 3] = vtr(vb_ + (16 * s2_ + 8) * VS + d2_ * 64); } \
            const bf16x8 vf_ = __builtin_shufflevector(vl_[i_ & 3], vh_[i_ & 3], 0, 1, 2, 3, 4, 5, 6, 7); \
            o[d_] = MFMA32(vf_, __builtin_bit_cast(bf16x8, pw_[st_]), o[d_]); } } while (0)
#define ATT_LOADK(t) do { _Pragma("unroll") for (int i_ = 0; i_ < NKC; ++i_) { const char* b_ = (DQK == 192 && i_ == 2) ? (const char*)(Kb + (size_t)(t) * 64 * kbp) : (const char*)(Ka + (size_t)(t) * 64 * kap); \
        kreg[i_] = *(const u32x4*)(b_ + koffB[i_]); } } while (0)
#define ATT_LOADV(t) do { const char* b_ = (const char*)(Vp + (size_t)(t) * 64 * vpp); _Pragma("unroll") for (int i_ = 0; i_ < 2; ++i_) vreg[i_] = *(const u32x4*)(b_ + voffB[i_]); } while (0)
#define ATT_STOREK(b) do { _Pragma("unroll") for (int i_ = 0; i_ < NKC; ++i_) *(LAS u32x4*)(lds + ((b) ? K_OFF1 : K_OFF0) + kdst[i_]) = kreg[i_]; } while (0)
#define ATT_STOREV(b) do { _Pragma("unroll") for (int i_ = 0; i_ < 2; ++i_) *(LAS u32x4*)(lds + ((b) ? V_OFF1 : V_OFF0) + vdst[i_]) = vreg[i_]; } while (0)
    const bool late = (__builtin_amdgcn_readfirstlane(tid >> 6) & 1) != 0;
#define ATT_ACT(tt_) (((tt_) >= wt_lo) && ((tt_) <= wt_hi))
#define ATT_SB() __builtin_amdgcn_sched_barrier(0)
    if constexpr (!AHEAD) {
        ATT_LOADK(t_hi); ATT_LOADV(t_hi); ATT_STOREK(t_hi & 1); ATT_STOREV(t_hi & 1); __syncthreads();
        for (int t = t_hi; t >= tlo; --t) {
            if (t > tlo) { ATT_LOADK(t - 1); ATT_LOADV(t - 1); }
            if (ATT_ACT(t)) { ATT_QK(sc0, sc1, t & 1); ATT_SMPV(sc0, sc1, t); }
            if (t > tlo) { ATT_STOREK((t - 1) & 1); ATT_STOREV((t - 1) & 1); }
            __syncthreads();
        }
    } else {
    ATT_LOADK(t_hi); ATT_LOADV(t_hi); ATT_STOREK(t_hi & 1); ATT_STOREV(t_hi & 1); __syncthreads();
    ATT_LOADK(t_hi - 1);
    if (ATT_ACT(t_hi)) ATT_QK(sc0, sc1, t_hi & 1);
    ATT_STOREK((t_hi - 1) & 1); __syncthreads();
    for (int t = t_hi; t > tlo; --t) {
        ATT_LOADK(max(t - 2, tlo)); ATT_LOADV(t - 1);
        ATT_SB();
        if (!late) { if (ATT_ACT(t - 1)) ATT_QK(sn0, sn1, (t - 1) & 1); }
        ATT_SB();
        if (ATT_ACT(t)) ATT_SMPV(sc0, sc1, t);
        ATT_SB();
        if (late) { if (ATT_ACT(t - 1)) ATT_QK(sn0, sn1, (t - 1) & 1); }
        ATT_SB();
        ATT_STOREK(t & 1); ATT_STOREV((t - 1) & 1);
        if (BIAS == 1) { if (t == t_dec) { float wm = m;
#pragma unroll
            for (int sh = 1; sh < 32; sh <<= 1) wm = fminf(wm, __shfl_xor(wm, sh));
            if (lane == 0) red[8 + (tid >> 6)] = wm; } }
        __syncthreads();
        if (BIAS == 1) { if (t == t_dec) {
            float qmax2 = red[0], mlo = red[8];
#pragma unroll
            for (int w = 1; w < 8; ++w) { qmax2 = fmaxf(qmax2, red[w]); mlo = fminf(mlo, red[8 + w]); }
            bool dead[2];
#pragma unroll
            for (int i = 0; i < 2; ++i) { const int tt = lane + 64 * i; const float kn2 = kn2row[tt];
                const float ub = sqrtf(qmax2 * kn2) * c * 1.001f - slope2 * (float)(q0blk - 64 * tt - 63) - mlo;
                dead[i] = (tt < t) && (ub <= -160.f); }
            const unsigned long long d0 = __ballot(dead[0]), d1 = __ballot(dead[1]);
            const int ndead = (~d0 != 0ull) ? (__ffsll((long long)~d0) - 1) : ((~d1 != 0ull) ? 64 + (__ffsll((long long)~d1) - 1) : 128);
            tlo = min(max(ndead, tlo), t - 1);
        } }
        sc0 = sn0; sc1 = sn1;
    }
    if (ATT_ACT(tlo)) ATT_SMPV(sc0, sc1, tlo);
    __syncthreads();
    }
#undef ATT_ACT
#undef ATT_SB
#undef ATT_QK
#undef ATT_KLD
#undef ATT_QLD
#undef ATT_SMPV
#undef ATT_LOADK
#undef ATT_LOADV
#undef ATT_STOREK
#undef ATT_STOREV
    m_io = m; l_io = l;
}
__device__ __forceinline__ void store_pairs(bf16* __restrict__ dst, int d, int ap, int hi, unsigned ax, unsigned ay, unsigned bx, unsigned by) {
    const auto rx = __builtin_amdgcn_permlane32_swap(ax, bx, false, false), ry = __builtin_amdgcn_permlane32_swap(ay, by, false, false);
    u32x4 w; w.x = rx[0]; w.y = ry[0]; w.z = rx[1]; w.w = ry[1];
    *(u32x4*)(dst + 32 * d + 16 * ap + 8 * hi) = w;
}
__device__ __forceinline__ void store_o(bf16* __restrict__ dst, const f32x16 (&o)[4], float inv, int hi) {
#pragma unroll
    for (int d = 0; d < 4; ++d)
#pragma unroll
        for (int ap = 0; ap < 2; ++ap) { const int r0 = 8 * ap;
            store_pairs(dst, d, ap, hi, cvtpk(o[d][r0] * inv, o[d][r0 + 1] * inv), cvtpk(o[d][r0 + 2] * inv, o[d][r0 + 3] * inv),
                                        cvtpk(o[d][r0 + 4] * inv, o[d][r0 + 5] * inv), cvtpk(o[d][r0 + 6] * inv, o[d][r0 + 7] * inv)); }
}
struct Ptrs { const bf16* proj; const bf16* qA; const bf16* kvA; bf16* mixed; const float* subln; const float* relb; const float* kn2; float lam, lam_init; };

__device__ __forceinline__ void unit_mla(LAS unsigned char* lds, const Ptrs& P, int b, int h, int qb) {
    int tid_ = threadIdx.x; asm volatile("" : "+v"(tid_));
    const int tid = tid_, lane = tid & 63, hi = lane >> 5, l32 = lane & 31, wid = __builtin_amdgcn_readfirstlane(tid >> 6);
    const size_t rowb = (size_t)b * SEQ; const int q0 = qb * 256, qrow = q0 + 32 * wid + l32;
    f32x16 o[4];
#pragma unroll
    for (int d = 0; d < 4; ++d)
#pragma unroll
        for (int r = 0; r < 16; ++r) o[d][r] = 0.f;
    float m = -1e30f, l = 0.f;
    flash_loop<192, 0, false>(lds, P.qA + (rowb + qrow) * NQ + h * 192, P.kvA + rowb * NKV + h * 256, NKV, P.proj + rowb * NINP + C_KROPE, NINP, P.kvA + rowb * NKV + h * 256 + 128, NKV,
                       0, q0 / 64 + 3, 0, q0 / 64 + (wid >> 1), 0.07216878364870323f * LOG2E, 0.f, nullptr, qrow, o, m, l);
    l += __shfl_xor(l, 32);
    store_o(P.mixed + (rowb + qrow) * DM + h * 128, o, 1.0f / l, hi);
}
__device__ __forceinline__ void unit_diff(LAS unsigned char* lds, const Ptrs& P, int b, int h, int qb) {
    int tid_ = threadIdx.x; asm volatile("" : "+v"(tid_));
    const int tid = tid_, lane = tid & 63, hi = lane >> 5, l32 = lane & 31, wid = __builtin_amdgcn_readfirstlane(tid >> 6);
    const size_t rowb = (size_t)b * SEQ; const int q0 = qb * 256, qrow = q0 + 32 * wid + l32;
    const float slope2 = exp2f(-2.0f * (float)(h + 1)) * LOG2E, c = 0.125f * LOG2E;
    const bf16* qp = P.proj + (rowb + qrow) * NINP + C_QB + h * 128; const bf16* kp = P.proj + rowb * NINP + C_KB + h * 128; const bf16* vp = P.proj + rowb * NINP + C_VB + h * 128;
    const int t_hi = q0 / 64 + 3, wt_hi = q0 / 64 + (wid >> 1);
    f32x16 o[4];
#pragma unroll
    for (int d = 0; d < 4; ++d)
#pragma unroll
        for (int r = 0; r < 16; ++r) o[d][r] = 0.f;
    float m = -1e30f, l = 0.f;
    const float* kn2 = P.kn2 + ((b * 4 + h) * 2) * 128;
    flash_loop<64, 1>(lds, qp + 64, kp + 64, NINP, kp, NINP, vp, NINP, 0, t_hi, 0, wt_hi, c, slope2, nullptr, qrow, o, m, l, kn2 + 128, q0);
    l += __shfl_xor(l, 32);
    LAS unsigned* stash = (LAS unsigned*)(lds + STASH_OFF) + tid;
    { const float f = P.lam / l;
#pragma unroll
      for (int d = 0; d < 4; ++d)
#pragma unroll
          for (int e = 0; e < 8; ++e) { stash[(d * 8 + e) * NTHREADS] = cvtpk(o[d][2 * e] * f, o[d][2 * e + 1] * f); o[d][2 * e] = 0.f; o[d][2 * e + 1] = 0.f; } }
    m = -1e30f; l = 0.f;
    flash_loop<64, 1>(lds, qp, kp, NINP, kp, NINP, vp, NINP, 0, t_hi, 0, wt_hi, c, slope2, nullptr, qrow, o, m, l, kn2, q0);
    l += __shfl_xor(l, 32);
    const float inv = 1.0f / l; float ss = 0.f;
#pragma unroll
    for (int d = 0; d < 4; ++d)
#pragma unroll
        for (int e = 0; e < 8; ++e) { const unsigned w = stash[(d * 8 + e) * NTHREADS];
            const float v0 = o[d][2 * e] * inv - __uint_as_float(w << 16), v1 = o[d][2 * e + 1] * inv - __uint_as_float(w & 0xffff0000u);
            o[d][2 * e] = v0; o[d][2 * e + 1] = v1; ss += v0 * v0 + v1 * v1; }
    ss += __shfl_xor(ss, 32);
    const float rs = (1.0f / sqrtf(ss * (1.f / 128.f) + EPS)) * (1.0f - P.lam_init);
    bf16* dst = P.mixed + (rowb + qrow) * DM + 1024 + h * 128;
#pragma unroll
    for (int d = 0; d < 4; ++d)
#pragma unroll
        for (int ap = 0; ap < 2; ++ap) { const int r0 = 8 * ap;
            const f32x4 g0 = *(const f32x4*)(P.subln + 32 * d + 16 * ap + 4 * hi), g1 = *(const f32x4*)(P.subln + 32 * d + 16 * ap + 8 + 4 * hi);
            store_pairs(dst, d, ap, hi, cvtpk(o[d][r0] * rs * g0[0], o[d][r0 + 1] * rs * g0[1]), cvtpk(o[d][r0 + 2] * rs * g0[2], o[d][r0 + 3] * rs * g0[3]),
                                        cvtpk(o[d][r0 + 4] * rs * g1[0], o[d][r0 + 5] * rs * g1[1]), cvtpk(o[d][r0 + 6] * rs * g1[2], o[d][r0 + 7] * rs * g1[3])); }
}
__device__ __forceinline__ void unit_band(LAS unsigned char* lds, const Ptrs& P, int b, int h, int qb) {
    int tid_ = threadIdx.x; asm volatile("" : "+v"(tid_));
    const int tid = tid_, lane = tid & 63, hi = lane >> 5, l32 = lane & 31, wid = __builtin_amdgcn_readfirstlane(tid >> 6);
    const size_t rowb = (size_t)b * SEQ; const int q0 = qb * 256, qrow = q0 + 32 * wid + l32;
    LAS float* tab = (LAS float*)(lds + MISC_OFF + 256);
    if (tid < 320) tab[tid] = P.relb[h * 320 + tid] * LOG2E;
    const int c0 = q0 / 64, cw = c0 + (wid >> 1);
    f32x16 o[4];
#pragma unroll
    for (int d = 0; d < 4; ++d)
#pragma unroll
        for (int r = 0; r < 16; ++r) o[d][r] = 0.f;
    float m = -1e30f, l = 0.f;
    const bf16* kp = P.proj + rowb * NINP + C_KC + h * 128;
    flash_loop<128, 2>(lds, P.proj + (rowb + qrow) * NINP + C_QC + h * 128, kp, NINP, kp, NINP, P.proj + rowb * NINP + C_VC + h * 128, NINP,
                       max(c0 - 8, 0), c0 + 3, max(cw - 8, 0), cw, 0.08838834764831845f * LOG2E, 0.f, tab, qrow, o, m, l);
    l += __shfl_xor(l, 32);
    store_o(P.mixed + (rowb + qrow) * DM + 1536 + h * 128, o, 1.0f / l, hi);
}
__device__ __forceinline__ int next_item(volatile LAS int* s_item, unsigned* ctr) {
    if (threadIdx.x == 0) *s_item = (int)atomicAdd(ctr, 1u);
    __syncthreads();
    const int item = __builtin_amdgcn_readfirstlane(*s_item);
    __syncthreads();
    return item;
}
__device__ __forceinline__ void attention_phase(LAS unsigned char* lds, const Ptrs& P, unsigned* ctr, int n_conv) {
    volatile LAS int* s_item = (volatile LAS int*)(lds + MISC_OFF);
    const int n_groups = n_conv > 0 ? 128 : 0, n_mixed = n_groups * 13;
    for (;;) {
        const int e = next_item(s_item, ctr);
        int item;
        if (e < n_mixed) { const int g = e / 13, r = e - g * 13;
            if (r >= 8) {
                int tid_ = threadIdx.x; asm volatile("" : "+v"(tid_));
                const int lane = tid_ & 63, wave = __builtin_amdgcn_readfirstlane(tid_ >> 6); LAS float* scr = (LAS float*)(lds + wave * 16384);
                const int c = 5 * g + (r - 8); unsigned char* ws = arg_ws();
                if (c < n_conv) {
#pragma unroll 1
                    for (int k = 0; k < CONV_CHUNK / NWAVES; ++k) { const int d = CONV_CHUNK * c + wave + NWAVES * k;
                        if (d < N_DEFER) { if (d < I_LAYER - I_EARLY) convert_item(0, I_EARLY + d, ws, scr, lane); else { const int d1 = d - (I_LAYER - I_EARLY); convert_item(d1 / I_LAYER + 1, d1 % I_LAYER, ws, scr, lane); } } }
                }
                continue;
            }
            item = 8 * g + r;
        } else item = e - n_mixed + 8 * n_groups;
        if (item >= 1024) break;
        if (item >= 696 && item < 952) { const int ci = item - 696; unit_band(lds, P, (ci >> 2) & 1, ci & 3, ci >> 3); }
        else { const int idx = item < 696 ? item : item - 256; const int qb = 31 - idx / 24, j = idx % 24;
            if (j < 16) unit_mla(lds, P, j >> 3, j & 7, qb); else unit_diff(lds, P, (j - 16) >> 2, (j - 16) & 3, qb); }
    }
}
#undef MFMA32
}
#define XB_TMO      128
#define XB_XCNT(j)  (256  + 64 * (j))
#define XB_XSUB(j)  (1280 + 64 * (j))
#define XB_XGEN(j)  (2304 + 64 * (j))
#define XB_TOP      3328
#define XB_TOPGEN   3392
#define XCD_BAR_WORDS 3456
#define XB_SPIN_CAP (1u << 18)

__device__ __forceinline__ unsigned xb_ld(unsigned* p)              { return __hip_atomic_load(p, __ATOMIC_RELAXED, __HIP_MEMORY_SCOPE_AGENT); }
__device__ __forceinline__ unsigned xb_add(unsigned* p, unsigned v) { return __hip_atomic_fetch_add(p, v, __ATOMIC_RELAXED, __HIP_MEMORY_SCOPE_AGENT); }
__device__ __forceinline__ unsigned xb_xcc_id() { return (unsigned)__builtin_amdgcn_s_getreg((3 << 11) | 20) & 0xFu; }
#define XB_SPIN(cond, bar) do { unsigned _sp = 0; while (cond) { __builtin_amdgcn_s_sleep(1); \
    if ((++_sp & 255u) == 0u) { if (xb_ld(&(bar)[XB_TMO])) break; if (_sp > XB_SPIN_CAP) { atomicAdd(&(bar)[XB_TMO], 1u); break; } } } } while (0)

struct XcdBarrier {
    unsigned* bar; unsigned x;
    volatile LAS unsigned* st;
};

__device__ __forceinline__ XcdBarrier xcd_barrier_post(unsigned* bar, volatile LAS unsigned* st) {
    XcdBarrier b; b.bar = bar; b.x = xb_xcc_id(); b.st = st;
    if (threadIdx.x == 0) (void)xb_add(&bar[XB_XCNT(b.x)], 1u);
    return b;
}
__device__ __forceinline__ void xcd_barrier_complete(unsigned* bar, unsigned x, unsigned& nloc, unsigned& nx) {
    const unsigned G = gridDim.x * gridDim.y * gridDim.z;
    unsigned sum, cnt, mine, sp = 0u;
    for (;;) {
        sum = 0u; cnt = 0u; mine = 0u;
#pragma unroll
        for (unsigned j = 0; j < 16; ++j) { const unsigned c = xb_ld(&bar[XB_XCNT(j)]); sum += c; cnt += (c > 0u) ? 1u : 0u; mine = (j == x) ? c : mine; }
        if (sum == G) break;
        __builtin_amdgcn_s_sleep(1);
        if ((++sp & 255u) == 0u) { if (xb_ld(&bar[XB_TMO])) break; if (sp > XB_SPIN_CAP) { atomicAdd(&bar[XB_TMO], 1u); break; } }
    }
    nloc = mine > 0u ? mine : 1u; nx = cnt > 0u ? cnt : 1u;
}

__device__ __forceinline__ void xcd_barrier(const XcdBarrier& b) {
    asm volatile("s_waitcnt vmcnt(0)" ::: "memory");
    __syncthreads();
    if (threadIdx.x == 0) {
        unsigned* bar = b.bar; asm volatile("" : "+s"(bar)); unsigned bx = b.x; asm volatile("" : "+s"(bx));
        __builtin_amdgcn_s_waitcnt(0);
        unsigned nloc = b.st[0], nx = b.st[1];
        if (nloc == 0u) { xcd_barrier_complete(bar, bx, nloc, nx); b.st[0] = nloc; b.st[1] = nx; }
        const unsigned old = xb_add(&bar[XB_XSUB(bx)], 1u);
        const unsigned gen = old / nloc;
        if (old + 1u == (gen + 1u) * nloc) {
            __builtin_amdgcn_fence(__ATOMIC_RELEASE, "agent");
            asm volatile("s_waitcnt vmcnt(0)" ::: "memory");
            const unsigned og = xb_add(&bar[XB_TOP], 1u);
            const unsigned tg = og / nx;
            if (og + 1u == (tg + 1u) * nx) xb_add(&bar[XB_TOPGEN], 1u);
            else XB_SPIN(xb_ld(&bar[XB_TOPGEN]) == tg, bar);
            __builtin_amdgcn_fence(__ATOMIC_ACQUIRE, "agent");
            xb_add(&bar[XB_XGEN(bx)], 1u);
            asm volatile("s_waitcnt vmcnt(0)" ::: "memory");
        } else {
            XB_SPIN(xb_ld(&bar[XB_XGEN(bx)]) == gen, bar);
            __builtin_amdgcn_fence(__ATOMIC_ACQUIRE, "agent");
            asm volatile("s_waitcnt vmcnt(0)" ::: "memory");
        }
    }
    __syncthreads();
}

struct Args { const float* in[18]; float* out; unsigned char* ws; int ph_lo, ph_hi; };
constexpr int N_PHASES = 2 + 6 * DEPTH;

__global__ void __launch_bounds__(NTHREADS, 2) fwd_mega(Args a) {
    extern __shared__ __attribute__((aligned(16))) unsigned char lds_raw[];
    LAS unsigned char* lds = (LAS unsigned char*)lds_raw;
    cg::grid_group grid = cg::this_grid();
    const int G = gridDim.x;
    unsigned char* ws = a.ws;
    float* xres = a.out;
    bf16* hn = (bf16*)(ws + WS_HN); bf16* proj = (bf16*)a.out;        bf16* qA = (bf16*)(ws + WS_QA); bf16* kvA = (bf16*)(ws + WS_KVA); bf16* hff = (bf16*)(ws + WS_HFF);
    bf16* xb = (bf16*)(ws + WS_XB); float* part = (float*)(ws + WS_PART);
    float* rope_tab = (float*)(ws + WS_ROPE);
    unsigned* ctl = (unsigned*)(ws + WS_CTL);
    const int lo = a.ph_lo, hi = a.ph_hi;
    if (threadIdx.x < 2) ((volatile LAS unsigned*)(lds + MISC_OFF + 64))[threadIdx.x] = 0u;
    __syncthreads();
    XcdBarrier xbar = xcd_barrier_post(ctl + CW_BAR, (volatile LAS unsigned*)(lds + MISC_OFF + 64));
#ifndef PH_MASK
#define PH_MASK 0x3ff
#endif
#define PH_BEGIN(k) if (((PH_MASK >> PH_SUB) & 1) && lo <= (k) && (k) < hi) { \
        int tid_ = threadIdx.x; asm volatile("" : "+v"(tid_));        \
        int bid_ = blockIdx.x, Go_ = G; asm volatile("" : "+s"(bid_), "+s"(Go_));        \
        const int bid = bid_, Gp = Go_; \
        const int tid = tid_, lane = tid & 63, wave = __builtin_amdgcn_readfirstlane(tid >> 6), gw = bid * NWAVES + wave, ngw = Gp * NWAVES; (void)lane; (void)gw; (void)ngw; (void)tid;
#define PH_END(k) } if (lo <= (k) && (k) + 1 < hi) { if (lo < 0) grid.sync(); else xcd_barrier(xbar); }

#define PH_SUB 9
    PH_BEGIN(0)
#undef PH_SUB
        LAS float* scr = (LAS float*)(lds + wave * 16384);
        for (int it = gw; it < I_EARLY; it += ngw) convert_item(0, it, ws, scr, lane);
        {
            const int gt = blockIdx.x * NTHREADS + tid, ngt = G * NTHREADS;
            constexpr int PADV = (NINP - NIN) * DM * 2 / 16;
            for (int i = gt; i < DEPTH * PADV; i += ngt) { const int l = i / PADV, r = i - l * PADV;
                ((u32x4*)(ws + WS_W + (size_t)l * W_LAYER + WO_IN + (size_t)NIN * DM * 2))[r] = (u32x4){0u, 0u, 0u, 0u}; }
            for (int i = gt; i < SEQ * 32; i += ngt) { const int pos = i >> 5, fi = i & 31;
                double f = 1.0; for (int k = 0; k < fi; ++k) f *= 0.74989420933245582;
                const float inv_freq = (float)f, ang = (float)pos * inv_freq;
                double rev = (double)ang * 0.15915494309189535; rev -= __builtin_rint(rev);
                const float rv = (float)rev;
                ((f32x2_t*)rope_tab)[i] = (f32x2_t){__builtin_amdgcn_cosf(rv), __builtin_amdgcn_sinf(rv)}; }
        }
        xb_rows_phase(arg_in(0), xb, part, gw, ngw, lane);
    PH_END(0)

    LAS float* rs0 = (LAS float*)(lds + MISC_OFF + 2048);
    LAS float* rs1 = rs0 + 256;
#pragma unroll 1
    for (int l = 0; l < DEPTH; ++l) {
        const int pb = 1 + 6 * l;
        unsigned char* wl = ws + WS_W + (size_t)l * W_LAYER;
#define PH_SUB 0
        PH_BEGIN(pb + 0)
#undef PH_SUB
            pg8::Gemm g{xb, (const bf16*)(wl + WO_IN), M, NINP, DM, DM}; pg8::StaticOrder S; S.init(M, NINP, Gp, bid);
            { pg8::Unit u0; S.next(0, u0); panel_rstd_from_part(part, u0.pm, rs0, tid); }
            pg8::EpiBf<0, true> E{proj, NINP, 1 << 20, C_KROPE, rope_tab, rs0};
            pg8::gemm_phase<pg8::EpiBf<0, true>, pg8::StaticOrder, true, true>(lds, g, S, E);
        PH_END(pb + 0)
#define PH_SUB 1
        PH_BEGIN(pb + 1)
#undef PH_SUB
            { pg8::Gemm g{proj, (const bf16*)(wl + WO_UQ), M, NQ, QR, NINP}; pg8::StaticOrder S; S.init(M, NQ, Gp, bid);
              { pg8::Unit u0; S.next(0, u0); panel_rstd_cqkv(proj, u0.pm, rs0, rs1, wave, lane); }
              pg8::EpiBf<0, true> E{qA, NQ, 192, 128, rope_tab, rs0};
              pg8::gemm_phase<pg8::EpiBf<0, true>, pg8::StaticOrder, true, true>(lds, g, S, E); }
            { pg8::Gemm g{proj + QR, (const bf16*)(wl + WO_UKV), M, NKV, KVR, NINP}; pg8::StaticOrder S; S.init(M, NKV, Gp, bid);
              pg8::EpiBf<0, false> E{kvA, NKV, 1, 0, nullptr, rs1};
              pg8::gemm_phase<pg8::EpiBf<0, false>, pg8::StaticOrder, true, true>(lds, g, S, E); }
            {
                float* kn2 = (float*)(ws + WS_CTL + 65536);
                for (int it = gw; it < 2048; it += ngw) { const int bb = it >> 10, hh = (it >> 8) & 3, mp = (it >> 7) & 1, tt = it & 127;
                    const u32x4* kp = (const u32x4*)(proj + ((size_t)bb * SEQ + 64 * tt + lane) * NINP + C_KB + hh * 128 + mp * 64);
                    float sq = 0.f;
#pragma unroll
                    for (int j = 0; j < 8; ++j) { const u32x4 w = kp[j];
#pragma unroll
                        for (int e = 0; e < 4; ++e) { const float f0 = __uint_as_float(w[e] << 16), f1 = __uint_as_float(w[e] & 0xffff0000u); sq += f0 * f0 + f1 * f1; } }
#pragma unroll
                    for (int sh = 1; sh < 64; sh <<= 1) sq = fmaxf(sq, __shfl_xor(sq, sh));
                    if (lane == 0) kn2[it] = sq; }
            }
        PH_END(pb + 1)
#define PH_SUB 2
        PH_BEGIN(pb + 2)
#undef PH_SUB
            att::Ptrs P; P.proj = proj; P.qA = qA; P.kvA = kvA; P.mixed = hn; P.subln = arg_in(11) + l * 128; P.relb = arg_in(12) + l * 4 * 320; P.kn2 = (const float*)(ws + WS_CTL + 65536);
            { const float s1 = wave_sum(arg_in(7)[l * 64 + lane] * arg_in(8)[l * 64 + lane]), s2 = wave_sum(arg_in(9)[l * 64 + lane] * arg_in(10)[l * 64 + lane]);
              P.lam_init = 0.8f - 0.6f * expf(-0.3f * (float)l); P.lam = expf(s1) - expf(s2) + P.lam_init; }
            att::attention_phase(lds, P, ctl + 64 * l, l == 0 ? N_CONV_CHUNKS : 0);
        PH_END(pb + 2)
#define PH_SUB 3
        PH_BEGIN(pb + 3)
#undef PH_SUB
            pg8::Gemm g{hn, (const bf16*)(wl + WO_O), M, DM, DM, DM}; pg8::StaticOrder S; S.init(M, DM, Gp, bid);
            pg8::EpiRes E{xb, part, DM};
            pg8::gemm_phase<pg8::EpiRes, pg8::StaticOrder, true, true>(lds, g, S, E);
        PH_END(pb + 3)
#define PH_SUB 4
        PH_BEGIN(pb + 4)
#undef PH_SUB
            pg8::Gemm g{xb, (const bf16*)(wl + WO_UP), M, DFF, DM, DM}; pg8::StaticOrder S; S.init(M, DFF, Gp, bid);
            { pg8::Unit u0; S.next(0, u0); panel_rstd_from_part(part, u0.pm, rs0, tid); }
            pg8::EpiBf<2, false> E{hff, DFF, 1, 0, nullptr, rs0};
            pg8::gemm_phase<pg8::EpiBf<2, false>, pg8::StaticOrder, true, true>(lds, g, S, E);
        PH_END(pb + 4)
#define PH_SUB 5
        PH_BEGIN(pb + 5)
#undef PH_SUB
            pg8::Gemm g{hff, (const bf16*)(wl + WO_DN), M, DM, DFF, DFF}; pg8::StaticOrder S; S.init(M, DM, Gp, bid);
            pg8::EpiRes E{xb, part, DM};
            pg8::gemm_phase<pg8::EpiRes, pg8::StaticOrder, true, true>(lds, g, S, E);
        PH_END(pb + 5)
    }
#define PH_SUB 6
    PH_BEGIN(N_PHASES - 1)
#undef PH_SUB
        final_norm_phase(xb, xres, arg_in(17), gw, ngw, lane);
    PH_END(N_PHASES - 1)
#undef PH_BEGIN
#undef PH_END
}

#ifndef MK_PER_PHASE
#define MK_PER_PHASE 0
#endif
extern "C" void kernel_launch(void* const* d_in, const int* in_sizes, int n_in, void* d_out, int out_size, void* d_ws, size_t ws_size, hipStream_t stream) {
    static int grid = 0;
    if (grid == 0) {
        if (n_in != 18 || out_size != M * DM || ws_size < WS_END) { fprintf(stderr, "kernel_launch: unexpected problem (n_in %d out %d ws %zu)\n", n_in, out_size, ws_size); grid = -1; return; }
        int dev = 0, cus = 0, per_cu = 0;
        (void)hipGetDevice(&dev); (void)hipDeviceGetAttribute(&cus, hipDeviceAttributeMultiprocessorCount, dev);
        if (hipFuncSetAttribute((const void*)fwd_mega, hipFuncAttributeMaxDynamicSharedMemorySize, LDS_BYTES) != hipSuccess) { fprintf(stderr, "kernel_launch: hipFuncSetAttribute failed\n"); grid = -1; return; }
        if (hipOccupancyMaxActiveBlocksPerMultiprocessor(&per_cu, (const void*)fwd_mega, NTHREADS, LDS_BYTES) != hipSuccess || per_cu < 1) per_cu = 1;
        (void)hipGetLastError();
        grid = cus * per_cu; if (grid <= 0) grid = 256;
    }
    if (grid < 0) return;
    (void)hipMemsetAsync((char*)d_ws + WS_CTL, 0, 32768, stream);
    Args a{};
    for (int i = 0; i < 18; ++i) a.in[i] = (const float*)d_in[i];
    a.out = (float*)d_out; a.ws = (unsigned char*)d_ws;
#if MK_PER_PHASE
    for (int p = 0; p < N_PHASES; ++p) { a.ph_lo = p; a.ph_hi = p + 1; hipLaunchKernelGGL(fwd_mega, dim3(grid), dim3(NTHREADS), LDS_BYTES, stream, a); }
#else
    a.ph_lo = 0; a.ph_hi = N_PHASES;
    void* args[] = {&a};
    hipError_t e = hipLaunchCooperativeKernel((const void*)fwd_mega, dim3(grid), dim3(NTHREADS), args, LDS_BYTES, stream);
    if (e != hipSuccess) fprintf(stderr, "kernel_launch: cooperative launch failed: %s (grid %d)\n", hipGetErrorString(e), grid);
#endif
}
```

```cpp
#include <hip/hip_runtime.h>
#include <hip/hip_cooperative_groups.h>
#include <cstdio>
#include <cstdint>
namespace cg = cooperative_groups;
namespace pg8 {
#define PG8_LAS __attribute__((address_space(3)))
typedef unsigned short bf16_t;
typedef short bf16x8 __attribute__((ext_vector_type(8)));
typedef float f32x4 __attribute__((ext_vector_type(4)));
typedef unsigned u32x4 __attribute__((ext_vector_type(4)));
constexpr int BM = 256, BK = 64, HALF = 128, HTB = HALF * BK * 2  , STAGE_BYTES = 8 * HTB, NXCD = 8, WGM = 8;

__host__ __device__ __forceinline__ int lds_byte(int r, int c) { const int st = (r >> 4) * 2 + (c >> 5), rr = r & 15, cc = c & 31, ob = rr * 64 + cc * 2; return st * 1024 + (ob ^ (((ob >> 9) & 1) << 5)); }
__host__ __device__ __forceinline__ void stage_rc(int b, int& R, int& C) { const int st = b / 1024, sb = b % 1024, swz = sb ^ (((sb >> 9) & 1) << 5); R = (st >> 1) * 16 + swz / 64; C = (st & 1) * 32 + (swz % 64) / 2; }
__host__ __device__ __forceinline__ int perm32(int rho) { const int n = rho >> 4, i = rho & 15; return 8 * (i >> 2) + 4 * n + (i & 3); }

struct Unit { int pm, pn; };
struct Gemm { const bf16_t* A; const bf16_t* Bt; int M, N, K, lda; };

struct StaticOrder {
    int nM, nN, nwg, G, c;
    __host__ __device__ void init(int M, int N, int G_, int c_) { nM = M / BM; nN = N / BM; nwg = nM * nN; G = G_; c = c_; }
    __host__ __device__ bool next(int i, Unit& u) const {
        const long L = (long)i * G + c; if (L >= nwg) return false;
        int wgid = (int)L; { const int q = nwg / NXCD, r = nwg % NXCD, xcd = wgid % NXCD, off = wgid / NXCD; wgid = (xcd < r ? xcd * (q + 1) : r * (q + 1) + (xcd - r) * q) + off; }
        const int nig = WGM * nN, gid = wgid / nig, fm = gid * WGM, gsz = (nM - fm) < WGM ? (nM - fm) : WGM;
        u.pm = fm + ((wgid % nig) % gsz); u.pn = (wgid % nig) / gsz; return true;
    }
    __device__ __forceinline__ void a_ready(const Unit&) const {}
    __device__ __forceinline__ void done(const Unit&) const {}
};

__device__ __forceinline__ unsigned cvt_pk_bf16(float lo, float hi) { unsigned r; asm volatile("v_cvt_pk_bf16_f32 %0, %1, %2" : "=v"(r) : "v"(lo), "v"(hi)); return r; }
typedef float f32x2 __attribute__((ext_vector_type(2)));
template <int ACT, bool ROPE> struct EpiBf {
    static constexpr bool PERM = true, AFTER_DRAIN = false;
    bf16_t* O; int ldc; int rope_period, rope_start; const float* rope_tab; const PG8_LAS float* rs;
    __device__ __forceinline__ void operator()(const f32x4 (&acc)[2][2][4][2], const Unit& u, int wr, int wc, int fr, int fq) const {
        const int row0 = u.pm * BM + wr * 64 + fr; const int colw = u.pn * BM + wc * 32; const int col0 = colw + 8 * fq;
#pragma unroll
        for (int bj = 0; bj < 2; ++bj) {
            bool rope = false; int pair0 = 0;
            if (ROPE) { const int sec = (colw + bj * HALF) % rope_period; rope = (sec >= rope_start) && (sec < rope_start + 64); pair0 = ((sec - rope_start) >> 1) + 4 * fq; }
#pragma unroll
            for (int ai = 0; ai < 2; ++ai)
#pragma unroll
                for (int m = 0; m < 4; ++m) {
                    const int row = row0 + ai * HALF + m * 16;
                    const float rsc = rs[wr * 64 + fr + ai * HALF + m * 16];
                    f32x4 v0 = acc[ai][bj][m][0] * rsc, v1 = acc[ai][bj][m][1] * rsc;
                    if (ACT == 2) {
#pragma unroll
                        for (int e = 0; e < 4; ++e) { const float a = fmaxf(v0[e], 0.f), b = fmaxf(v1[e], 0.f); v0[e] = a * a; v1[e] = b * b; }
                    }
                    if (ROPE) { if (rope) {
                        const float* tp = rope_tab + ((size_t)(row & 8191) * 32 + pair0) * 2;
                        const f32x4 t0 = *(const f32x4*)tp, t1 = *(const f32x4*)(tp + 4);
                        f32x4 r0, r1;
                        r0[0] = v0[0] * t0[0] - v0[1] * t0[1]; r0[1] = v0[1] * t0[0] + v0[0] * t0[1];
                        r0[2] = v0[2] * t0[2] - v0[3] * t0[3]; r0[3] = v0[3] * t0[2] + v0[2] * t0[3];
                        r1[0] = v1[0] * t1[0] - v1[1] * t1[1]; r1[1] = v1[1] * t1[0] + v1[0] * t1[1];
                        r1[2] = v1[2] * t1[2] - v1[3] * t1[3]; r1[3] = v1[3] * t1[2] + v1[2] * t1[3];
                        v0 = r0; v1 = r1; } }
                    u32x4 w; w.x = cvt_pk_bf16(v0[0], v0[1]); w.y = cvt_pk_bf16(v0[2], v0[3]); w.z = cvt_pk_bf16(v1[0], v1[1]); w.w = cvt_pk_bf16(v1[2], v1[3]);
                    *(u32x4*)(O + (size_t)row * ldc + col0 + bj * HALF) = w;
                }
        }
    }
};
struct EpiRes {
    static constexpr bool PERM = true, AFTER_DRAIN = false;
    bf16_t* xb; float* part; int ldc;
    __device__ __forceinline__ void operator()(const f32x4 (&acc)[2][2][4][2], const Unit& u, int wr, int wc, int fr, int fq) const {
        const int col0 = u.pn * BM + wc * 32 + 8 * fq;
#pragma unroll
        for (int ai = 0; ai < 2; ++ai)
#pragma unroll
            for (int m = 0; m < 4; ++m) { const int row = u.pm * BM + ai * HALF + wr * 64 + m * 16 + fr; const size_t off = (size_t)row * ldc + col0;
                u32x4 bs[2];
#pragma unroll
                for (int bj = 0; bj < 2; ++bj) bs[bj] = *(const u32x4*)(xb + off + bj * HALF);
                float ss = 0.f;
#pragma unroll
                for (int bj = 0; bj < 2; ++bj) { const u32x4 b = bs[bj]; const f32x4 a0 = acc[ai][bj][m][0], a1 = acc[ai][bj][m][1];
                    const float o0 = __uint_as_float(b.x << 16) + a0[0], o1 = __uint_as_float(b.x & 0xffff0000u) + a0[1], o2 = __uint_as_float(b.y << 16) + a0[2], o3 = __uint_as_float(b.y & 0xffff0000u) + a0[3];
                    const float o4 = __uint_as_float(b.z << 16) + a1[0], o5 = __uint_as_float(b.z & 0xffff0000u) + a1[1], o6 = __uint_as_float(b.w << 16) + a1[2], o7 = __uint_as_float(b.w & 0xffff0000u) + a1[3];
                    ss += ((o0 * o0 + o1 * o1) + (o2 * o2 + o3 * o3)) + ((o4 * o4 + o5 * o5) + (o6 * o6 + o7 * o7));
                    u32x4 w; w.x = cvt_pk_bf16(o0, o1); w.y = cvt_pk_bf16(o2, o3); w.z = cvt_pk_bf16(o4, o5); w.w = cvt_pk_bf16(o6, o7);
                    *(u32x4*)(xb + off + bj * HALF) = w; }
                ss += __shfl_xor(ss, 16); ss += __shfl_xor(ss, 32);
                if (fq == 0) part[(size_t)row * 32 + u.pn * 4 + wc] = ss;
            }
    }
};
template <class Epi, class Sched, bool ALIGN_EPI = false, bool SP2 = false>
__device__ __forceinline__ void gemm_phase(PG8_LAS unsigned char* lds, const Gemm g, const Sched& S, const Epi& E) {
    int tid_ = threadIdx.x; asm volatile("" : "+v"(tid_));
    const int tid = tid_, wid = __builtin_amdgcn_readfirstlane(tid >> 6), lane = tid & 63, wr = wid >> 2, wc = wid & 3, fr = lane & 15, fq = lane >> 4;
    int K_ = g.K, lda_ = g.lda; asm volatile("" : "+s"(K_), "+s"(lda_));
    const int K = K_, nt = K / BK, LDA = lda_;
    unsigned voffA[2], voffB[2];
#pragma unroll
    for (int i = 0; i < 2; ++i) { int R, C; stage_rc(tid * 16 + i * 8192, R, C); const int Rb = Epi::PERM ? ((R & ~31) + perm32(R & 31)) : R;
        voffA[i] = (unsigned)(R * LDA + C) * 2u; voffB[i] = (unsigned)(Rb * K + C) * 2u; }
    const size_t kstep = (size_t)(BK * 2);
    const size_t hstep = (size_t)HALF * K * 2;
    const size_t tstep = 2 * hstep; const size_t hstepA = (size_t)HALF * LDA * 2, tstepA = 2 * hstepA;
    const unsigned ldsw = (unsigned)wid * 1024u;
    const int aoff = lds_byte(wr * 64 + fr, fq * 8), boff = lds_byte(wc * 32 + fr, fq * 8);
#define PG8_SA(b, h) (((b) * 2 + (h)) * HTB)
#define PG8_SB(b, h) ((4 + (b) * 2 + (h)) * HTB)
#define PG8_STAGE(bufoff, gbase, voff) do { _Pragma("unroll") for (int _i = 0; _i < 2; ++_i) \
        __builtin_amdgcn_global_load_lds((const unsigned*)((const char*)(gbase) + (voff)[_i]), (PG8_LAS unsigned*)(lds + (bufoff) + ldsw + _i * 8192), 16, 0, 0); } while (0)
#define PG8_LDA(dst, b, h) do { _Pragma("unroll") for (int m = 0; m < 4; ++m) _Pragma("unroll") for (int k = 0; k < 2; ++k) dst[m][k] = *(const PG8_LAS bf16x8*)(lds + PG8_SA(b, h) + aoff + m * 2048 + k * 1024); } while (0)
#define PG8_LDB(dst, b, h) do { _Pragma("unroll") for (int n = 0; n < 2; ++n) _Pragma("unroll") for (int k = 0; k < 2; ++k) dst[n][k] = *(const PG8_LAS bf16x8*)(lds + PG8_SB(b, h) + boff + n * 2048 + k * 1024); } while (0)
#define PG8_MMA(ai, bj, At, Bt) do { __builtin_amdgcn_s_setprio(1); _Pragma("unroll") for (int m = 0; m < 4; ++m) _Pragma("unroll") for (int n = 0; n < 2; ++n) _Pragma("unroll") for (int k = 0; k < 2; ++k) \
        acc[ai][bj][m][n] = __builtin_amdgcn_mfma_f32_16x16x32_bf16(Bt[n][k], At[m][k], acc[ai][bj][m][n], 0, 0, 0); __builtin_amdgcn_s_setprio(0); } while (0)
#define PG8_WAIT_V(n) asm volatile("s_waitcnt vmcnt(" #n ")" ::: "memory")
#define PG8_WAIT_L(n) asm volatile("s_waitcnt lgkmcnt(" #n ")" ::: "memory")
#define PG8_BAR __builtin_amdgcn_s_barrier()
#define PG8_SCHED __builtin_amdgcn_sched_barrier(0)
    Unit cur, nxt; int ui = 0;
    if (!S.next(0, cur)) return;
    f32x4 acc[2][2][4][2];
#pragma unroll
    for (int a = 0; a < 2; ++a)
#pragma unroll
        for (int b = 0; b < 2; ++b)
#pragma unroll
            for (int m = 0; m < 4; ++m)
#pragma unroll
                for (int n = 0; n < 2; ++n) acc[a][b][m][n] = (f32x4){0.f, 0.f, 0.f, 0.f};
    bf16x8 At[4][2], B0[2][2], B1[2][2];
    const char* cA = (const char*)g.A + (size_t)cur.pm * tstepA; const char* cB = (const char*)g.Bt + (size_t)cur.pn * tstep;
    S.a_ready(cur);
    if constexpr (SP2) {
        PG8_STAGE(PG8_SB(0, 0), cB, voffB); PG8_STAGE(PG8_SB(0, 1), cB + hstep, voffB); PG8_STAGE(PG8_SA(0, 0), cA, voffA); PG8_STAGE(PG8_SA(0, 1), cA + hstepA, voffA);
        if (wr == 1) PG8_BAR;
        PG8_WAIT_V(2); PG8_BAR;
        PG8_STAGE(PG8_SB(1, 0), cB + kstep, voffB); PG8_STAGE(PG8_SA(1, 0), cA + kstep, voffA); PG8_STAGE(PG8_SB(1, 1), cB + hstep + kstep, voffB);
        PG8_WAIT_V(6); PG8_BAR;
    } else {
        PG8_STAGE(PG8_SB(0, 0), cB, voffB); PG8_STAGE(PG8_SA(0, 0), cA, voffA); PG8_STAGE(PG8_SB(0, 1), cB + hstep, voffB); PG8_STAGE(PG8_SA(0, 1), cA + hstepA, voffA);
        if (wr == 1) PG8_BAR;
        PG8_WAIT_V(4); PG8_BAR;
        PG8_STAGE(PG8_SB(1, 0), cB + kstep, voffB); PG8_STAGE(PG8_SA(1, 0), cA + kstep, voffA); PG8_STAGE(PG8_SB(1, 1), cB + hstep + kstep, voffB);
        PG8_WAIT_V(6); PG8_BAR;
    }
    for (;;) {
        const bool has_next = S.next(ui + 1, nxt);
        const char* nA = has_next ? (const char*)g.A + (size_t)nxt.pm * tstepA : cA; const char* nB = has_next ? (const char*)g.Bt + (size_t)nxt.pn * tstep : cB;
        for (int t = 0; t < nt; t += 2) {
            const bool last = (t == nt - 2);
            const char* a1 = cA + (size_t)(t + 1) * kstep;
            const char* a2 = last ? nA : cA + (size_t)(t + 2) * kstep; const char* b2 = last ? nB : cB + (size_t)(t + 2) * kstep;
            const char* a3 = a2 + kstep; const char* b3 = b2 + kstep;
            if (last && has_next) S.a_ready(nxt);
            if constexpr (SP2) {
            PG8_LDB(B0, 0, 0); PG8_LDB(B1, 0, 1); PG8_SCHED; PG8_LDA(At, 0, 0); PG8_STAGE(PG8_SA(1, 1), a1 + hstepA, voffA);
            PG8_WAIT_V(8); PG8_WAIT_L(0); PG8_BAR; PG8_MMA(0, 0, At, B0); PG8_MMA(0, 1, At, B1); PG8_BAR; PG8_SCHED;
            PG8_LDA(At, 0, 1); PG8_STAGE(PG8_SB(0, 0), b2, voffB); PG8_STAGE(PG8_SB(0, 1), b2 + hstep, voffB); PG8_STAGE(PG8_SA(0, 0), a2, voffA);
            PG8_WAIT_V(8); PG8_WAIT_L(0); PG8_BAR; PG8_MMA(1, 0, At, B0); PG8_MMA(1, 1, At, B1); PG8_BAR; PG8_SCHED;
            PG8_LDB(B0, 1, 0); PG8_LDB(B1, 1, 1); PG8_SCHED; PG8_LDA(At, 1, 0); PG8_STAGE(PG8_SA(0, 1), a2 + hstepA, voffA);
            PG8_WAIT_V(8); PG8_WAIT_L(0); PG8_BAR; PG8_MMA(0, 0, At, B0); PG8_MMA(0, 1, At, B1); PG8_BAR; PG8_SCHED;
            PG8_LDA(At, 1, 1); PG8_STAGE(PG8_SB(1, 0), b3, voffB); PG8_STAGE(PG8_SB(1, 1), b3 + hstep, voffB); PG8_STAGE(PG8_SA(1, 0), a3, voffA);
            PG8_WAIT_V(8); PG8_WAIT_L(0); PG8_BAR; PG8_MMA(1, 0, At, B0); PG8_MMA(1, 1, At, B1); PG8_BAR; PG8_SCHED;
            } else {
            PG8_LDB(B0, 0, 0); PG8_SCHED; PG8_LDA(At, 0, 0); PG8_STAGE(PG8_SA(1, 1), a1 + hstepA, voffA);
            PG8_WAIT_L(8); PG8_BAR; PG8_WAIT_L(0); PG8_MMA(0, 0, At, B0); PG8_BAR; PG8_SCHED;
            PG8_LDB(B1, 0, 1); PG8_STAGE(PG8_SB(0, 0), b2, voffB);
            PG8_BAR; PG8_WAIT_L(0); PG8_MMA(0, 1, At, B1); PG8_BAR;
            PG8_LDA(At, 0, 1); PG8_STAGE(PG8_SA(0, 0), a2, voffA);
            PG8_BAR; PG8_WAIT_L(0); PG8_MMA(1, 0, At, B0); PG8_BAR; PG8_SCHED;
            PG8_STAGE(PG8_SB(0, 1), b2 + hstep, voffB);
            PG8_WAIT_V(6); PG8_BAR; PG8_MMA(1, 1, At, B1); PG8_BAR;
            PG8_LDB(B0, 1, 0); PG8_SCHED; PG8_LDA(At, 1, 0); PG8_STAGE(PG8_SA(0, 1), a2 + hstepA, voffA);
            PG8_WAIT_L(8); PG8_BAR; PG8_WAIT_L(0); PG8_MMA(0, 0, At, B0); PG8_BAR; PG8_SCHED;
            PG8_LDB(B1, 1, 1); PG8_STAGE(PG8_SB(1, 0), b3, voffB);
            PG8_BAR; PG8_WAIT_L(0); PG8_MMA(0, 1, At, B1); PG8_BAR;
            PG8_LDA(At, 1, 1); PG8_STAGE(PG8_SA(1, 0), a3, voffA);
            PG8_BAR; PG8_WAIT_L(0); PG8_MMA(1, 0, At, B0); PG8_BAR; PG8_SCHED;
            PG8_STAGE(PG8_SB(1, 1), b3 + hstep, voffB);
            PG8_WAIT_V(6); PG8_BAR; PG8_MMA(1, 1, At, B1); PG8_BAR;
            }
        }
        if constexpr (ALIGN_EPI) { if (wr == 0) PG8_BAR; }
        if constexpr (!Epi::AFTER_DRAIN) { E(acc, cur, wr, wc, fr, fq); S.done(cur); }
        if (!has_next) break;
#pragma unroll
        for (int a = 0; a < 2; ++a)
#pragma unroll
            for (int b = 0; b < 2; ++b)
#pragma unroll
                for (int m = 0; m < 4; ++m)
#pragma unroll
                    for (int n = 0; n < 2; ++n) acc[a][b][m][n] = (f32x4){0.f, 0.f, 0.f, 0.f};
        cur = nxt; cA = nA; cB = nB; ++ui;
        if constexpr (ALIGN_EPI) { if (wr == 1) PG8_BAR; }
    }
    PG8_WAIT_V(0);
    if constexpr (!ALIGN_EPI) { if (wr == 0) PG8_BAR; }
    PG8_BAR;
    if constexpr (Epi::AFTER_DRAIN) { E.fused(acc, cur, wr, wc, fr, fq, lds, wid, lane); S.done(cur); }
#undef PG8_SA
#undef PG8_SB
#undef PG8_STAGE
#undef PG8_LDA
#undef PG8_LDB
#undef PG8_MMA
#undef PG8_WAIT_V
#undef PG8_WAIT_L
#undef PG8_BAR
#undef PG8_SCHED
}
}
#define LAS __attribute__((address_space(3)))
typedef unsigned short bf16;
typedef float f32x4 __attribute__((ext_vector_type(4)));
typedef unsigned u32x4 __attribute__((ext_vector_type(4)));
typedef unsigned u32x2 __attribute__((ext_vector_type(2)));
constexpr int BATCH = 2, SEQ = 8192, DM = 2048, M = BATCH * SEQ, DEPTH = 2;
constexpr int NIN = 3648, NINP = 3840, QR = 384, KVR = 128, NQ = 1536, NKV = 2048, DFF = 8192;
constexpr int C_KROPE = 512, C_QB = 576, C_KB = 1088, C_VB = 1600, C_QC = 2112, C_KC = 2624, C_VC = 3136;
constexpr float EPS = 1e-6f, LOG2E = 1.4426950408889634f;
constexpr size_t MiB = 1u << 20;
constexpr size_t WS_CTL = 0, WS_ROPE = 1 * MiB, WS_PART = 4 * MiB, WS_W = 6 * MiB, W_LAYER = 90 * MiB;
constexpr size_t WO_IN = 0, WO_UQ = 15 * MiB, WO_UKV = 17 * MiB, WO_O = 18 * MiB, WO_UP = 26 * MiB, WO_DN = 58 * MiB;
constexpr size_t WS_XB = 186 * MiB, WS_HN = 250 * MiB, WS_QA = 314 * MiB, WS_KVA = 362 * MiB, WS_HFF = 250 * MiB, WS_END = 506 * MiB;
static_assert((size_t)NINP * DM * 2 <= 15 * MiB && (size_t)NQ * QR * 2 <= 2 * MiB && (size_t)M * NINP * 2 <= 120 * MiB && (size_t)M * NQ * 2 <= 48 * MiB && (size_t)M * DFF * 2 <= 256 * MiB, "ws map");
constexpr int CW_BAR = 4096;
constexpr int LDS_BYTES = 147456, MISC_OFF = 131072;
constexpr int NTHREADS = 512, NWAVES = 8;

typedef float f32x2_t __attribute__((ext_vector_type(2))); typedef __bf16 bf16x2_t __attribute__((ext_vector_type(2)));
__device__ __forceinline__ unsigned cvtpk(float lo, float hi) { f32x2_t v = {lo, hi}; bf16x2_t b = __builtin_convertvector(v, bf16x2_t); return __builtin_bit_cast(unsigned, b); }
__device__ __forceinline__ float wave_sum(float v) {
#pragma unroll
    for (int o = 1; o < 64; o <<= 1) v += __shfl_xor(v, o);
    return v;
}
#define LDS_WAIT() asm volatile("s_waitcnt lgkmcnt(0)" ::: "memory")

__device__ __forceinline__ int dstmap(int mode, int n) {
    if (mode == 1) { if (n >= 512 && n < 576) { const int i = n - 512; return 512 + (i < 32 ? 2 * i : 2 * (i - 32) + 1); } return n; }
    if (mode == 2) { const int hh = n / 192; int r = n - hh * 192; if (r >= 128) { const int i = r - 128; r = 128 + (i < 32 ? 2 * i : 2 * (i - 32) + 1); } return hh * 192 + r; }
    return n;
}
__device__ __forceinline__ void transpose_item(const float* __restrict__ W, int K, int N, const float* __restrict__ g, bf16* __restrict__ WT, int mode, LAS float* scr, int item, int lane) {
    const int nblk = N / 32, kb = item / nblk, nb = item - kb * nblk, k0 = 64 * kb, n0 = 32 * nb;
    f32x4 v[8]; const int kr = lane >> 3, n4 = (lane & 7) * 4;
#pragma unroll
    for (int i = 0; i < 8; ++i) v[i] = *(const f32x4*)(W + (size_t)(k0 + 8 * i + kr) * N + n0 + n4);
#pragma unroll
    for (int i = 0; i < 8; ++i) { const int kk = 8 * i + kr; const float gg = g ? g[k0 + kk] : 1.0f;
        scr[kk * 33 + n4 + 0] = v[i].x * gg; scr[kk * 33 + n4 + 1] = v[i].y * gg; scr[kk * 33 + n4 + 2] = v[i].z * gg; scr[kk * 33 + n4 + 3] = v[i].w * gg; }
    LDS_WAIT(); asm volatile("" ::: "memory");
    const int c = lane & 7;
#pragma unroll
    for (int j = 0; j < 4; ++j) { const int n = (lane >> 3) + 8 * j; const LAS float* s = scr + (8 * c) * 33 + n;
        u32x4 o; o.x = cvtpk(s[0 * 33], s[1 * 33]); o.y = cvtpk(s[2 * 33], s[3 * 33]); o.z = cvtpk(s[4 * 33], s[5 * 33]); o.w = cvtpk(s[6 * 33], s[7 * 33]);
        *(u32x4*)(WT + (size_t)dstmap(mode, n0 + n) * K + k0 + 8 * c) = o; }
    LDS_WAIT(); asm volatile("" ::: "memory");
}
__device__ __forceinline__ void xb_rows_phase(const float* __restrict__ x, bf16* __restrict__ xb, float* __restrict__ part, int gw, int ngw, int lane) {
    for (int mrow = gw; mrow < M; mrow += ngw) {
        const f32x4* xr = (const f32x4*)(x + (size_t)mrow * DM) + 2 * lane;
        f32x4 v[8]; float s = 0.f;
#pragma unroll
        for (int j = 0; j < 4; ++j) { v[2 * j] = xr[128 * j]; v[2 * j + 1] = xr[128 * j + 1]; }
#pragma unroll
        for (int j = 0; j < 8; ++j) s += (v[j].x * v[j].x + v[j].y * v[j].y) + (v[j].z * v[j].z + v[j].w * v[j].w);
        s = wave_sum(s);
        u32x4* o16 = (u32x4*)(xb + (size_t)mrow * DM) + lane;
#pragma unroll
        for (int j = 0; j < 4; ++j) { u32x4 w; w.x = cvtpk(v[2 * j].x, v[2 * j].y); w.y = cvtpk(v[2 * j].z, v[2 * j].w); w.z = cvtpk(v[2 * j + 1].x, v[2 * j + 1].y); w.w = cvtpk(v[2 * j + 1].z, v[2 * j + 1].w); o16[64 * j] = w; }
        if (lane < 32) part[(size_t)mrow * 32 + lane] = lane == 0 ? s : 0.f;
    }
}
__device__ __forceinline__ void panel_rstd_from_part(const float* __restrict__ part, int pm, LAS float* rs, int tid) {
    const int row = tid >> 1, half = tid & 1;
    const f32x4* p = (const f32x4*)(part + ((size_t)pm * 256 + row) * 32 + half * 16);
    const f32x4 a = p[0], b = p[1], c = p[2], d = p[3];
    float sm = ((a.x + a.y) + (a.z + a.w)) + ((b.x + b.y) + (b.z + b.w)) + ((c.x + c.y) + (c.z + c.w)) + ((d.x + d.y) + (d.z + d.w));
    sm += __shfl_xor(sm, 1);
    if (half == 0) rs[row] = 1.0f / sqrtf(sm * (1.f / DM) + EPS);
    __syncthreads();
}
__device__ __forceinline__ void panel_rstd_cqkv(const bf16* __restrict__ proj, int pm, LAS float* rq, LAS float* rkv, int wave, int lane) {
#pragma unroll 4
    for (int i = 0; i < 32; ++i) { const int row = wave * 32 + i;
        const u32x4 w = *((const u32x4*)(proj + ((size_t)pm * 256 + row) * NINP) + lane);
        float sq = 0.f;
#pragma unroll
        for (int e = 0; e < 4; ++e) { const float f0 = __uint_as_float(w[e] << 16), f1 = __uint_as_float(w[e] & 0xffff0000u); sq += f0 * f0 + f1 * f1; }
        const float tq = wave_sum(lane < 48 ? sq : 0.f), tkv = wave_sum(lane < 48 ? 0.f : sq);
        if (lane == 0) { rq[row] = 1.0f / sqrtf(tq * (1.f / QR) + EPS); rkv[row] = 1.0f / sqrtf(tkv * (1.f / KVR) + EPS); } }
    __syncthreads();
}
__device__ __forceinline__ void final_norm_phase(const bf16* __restrict__ xb, float* __restrict__ out, const float* __restrict__ g, int gw, int ngw, int lane) {
    for (int mrow = gw; mrow < M; mrow += ngw) {
        const u32x4* xr = (const u32x4*)(xb + (size_t)mrow * DM) + lane; const f32x4* gr = (const f32x4*)g + 2 * lane;
        f32x4 v[8]; float s = 0.f;
#pragma unroll
        for (int j = 0; j < 4; ++j) { const u32x4 w = xr[64 * j];
            v[2 * j] = (f32x4){__uint_as_float(w.x << 16), __uint_as_float(w.x & 0xffff0000u), __uint_as_float(w.y << 16), __uint_as_float(w.y & 0xffff0000u)};
            v[2 * j + 1] = (f32x4){__uint_as_float(w.z << 16), __uint_as_float(w.z & 0xffff0000u), __uint_as_float(w.w << 16), __uint_as_float(w.w & 0xffff0000u)}; }
#pragma unroll
        for (int j = 0; j < 8; ++j) s += (v[j].x * v[j].x + v[j].y * v[j].y) + (v[j].z * v[j].z + v[j].w * v[j].w);
        const float rstd = 1.0f / sqrtf(wave_sum(s) * (1.f / DM) + EPS);
        f32x4* orow = (f32x4*)(out + (size_t)mrow * DM) + 2 * lane;
#pragma unroll
        for (int j = 0; j < 4; ++j) { orow[128 * j] = v[2 * j] * rstd * gr[128 * j]; orow[128 * j + 1] = v[2 * j + 1] * rstd * gr[128 * j + 1]; }
    }
}
__device__ __forceinline__ const float* arg_in(int i) { asm volatile("" : "+s"(i)); return ((const float* const __attribute__((address_space(4)))*)__builtin_amdgcn_kernarg_segment_ptr())[i]; }
constexpr int I_IN = (DM / 64) * (NIN / 32), I_UQ = (QR / 64) * (NQ / 32), I_UKV = (KVR / 64) * (NKV / 32), I_O = (DM / 64) * (DM / 32), I_UP = (DM / 64) * (DFF / 32), I_DN = (DFF / 64) * (DM / 32);
constexpr int I_LAYER = I_IN + I_UQ + I_UKV + I_O + I_UP + I_DN;
__device__ __forceinline__ unsigned char* arg_ws() { int o = 19; asm volatile("" : "+s"(o)); return ((unsigned char* const __attribute__((address_space(4)))*)__builtin_amdgcn_kernarg_segment_ptr())[o]; }
constexpr int I_EARLY = I_IN + I_UQ + I_UKV;
constexpr int N_DEFER = (I_LAYER - I_EARLY) + (DEPTH - 1) * I_LAYER;
constexpr int CONV_CHUNK = 64, N_CONV_CHUNKS = (N_DEFER + CONV_CHUNK - 1) / CONV_CHUNK;
__device__ __forceinline__ void convert_item(int l, int r, unsigned char* ws, LAS float* scr, int lane) {
    unsigned char* wl = ws + WS_W + (size_t)l * W_LAYER;
    if (r < I_IN) { transpose_item(arg_in(2) + (size_t)l * DM * NIN, DM, NIN, arg_in(1) + l * DM, (bf16*)(wl + WO_IN), 1, scr, r, lane); return; } r -= I_IN;
    if (r < I_UQ) { transpose_item(arg_in(5) + (size_t)l * QR * NQ, QR, NQ, arg_in(3) + l * QR, (bf16*)(wl + WO_UQ), 2, scr, r, lane); return; } r -= I_UQ;
    if (r < I_UKV) { transpose_item(arg_in(6) + (size_t)l * KVR * NKV, KVR, NKV, arg_in(4) + l * KVR, (bf16*)(wl + WO_UKV), 0, scr, r, lane); return; } r -= I_UKV;
    if (r < I_O) { transpose_item(arg_in(13) + (size_t)l * DM * DM, DM, DM, nullptr, (bf16*)(wl + WO_O), 0, scr, r, lane); return; } r -= I_O;
    if (r < I_UP) { transpose_item(arg_in(15) + (size_t)l * DM * DFF, DM, DFF, arg_in(14) + l * DM, (bf16*)(wl + WO_UP), 0, scr, r, lane); return; } r -= I_UP;
    transpose_item(arg_in(16) + (size_t)l * DFF * DM, DFF, DM, nullptr, (bf16*)(wl + WO_DN), 0, scr, r, lane);
}
namespace att {
typedef short bf16x8 __attribute__((ext_vector_type(8)));
typedef short s16x4 __attribute__((ext_vector_type(4)));
typedef short v4i16_t __attribute__((ext_vector_type(4)));
typedef float f32x16 __attribute__((ext_vector_type(16)));
constexpr int VS = 320, VBYTES = 64 * VS, KMAXB = 64 * (192 * 2 + 16);
constexpr int V_OFF0 = 0, V_OFF1 = VBYTES, K_OFF0 = 2 * VBYTES;
constexpr int QPARK_OFF = K_OFF0 + 2 * KMAXB;
constexpr int STASH_OFF = K_OFF0 + 2 * 64 * (64 * 2 + 16);
static_assert(QPARK_OFF + 8 * 4096 <= MISC_OFF && STASH_OFF + 65536 <= MISC_OFF, "attention LDS");
__device__ __forceinline__ s16x4 vtr(const LAS unsigned char* p) { return __builtin_bit_cast(s16x4, __builtin_amdgcn_ds_read_tr16_b64_v4i16((LAS v4i16_t*)p)); }
#define MFMA32(a, b, c) __builtin_amdgcn_mfma_f32_32x32x16_bf16((a), (b), (c), 0, 0, 0)
#define ATT_THR 8.0f

template <int DQK, int BIAS, bool AHEAD = true>
__device__ __forceinline__ void flash_loop(LAS unsigned char* lds, const bf16* __restrict__ Qrow,
        const bf16* __restrict__ Ka, int kap, const bf16* __restrict__ Kb, int kbp, const bf16* __restrict__ Vp, int vpp,
        int t_lo, int t_hi, int wt_lo, int wt_hi, float c, float slope2, const LAS float* tab, int qpos,
        f32x16 (&o)[4], float& m_io, float& l_io, const float* __restrict__ kn2row = nullptr, int q0blk = 0) {
    int tid_ = threadIdx.x; asm volatile("" : "+v"(tid_));
    const int tid = tid_, lane = tid & 63, hi = lane >> 5, l32 = lane & 31;
    constexpr int KS = DQK * 2 + 16, CPR = DQK / 8, NKC = DQK / 64, NDS = DQK / 16;
    constexpr int NQR = (DQK == 192 && AHEAD) ? 8 : NDS;
    bf16x8 qf[NQR];
#pragma unroll
    for (int ds = 0; ds < NQR; ++ds) qf[ds] = *(const bf16x8*)(Qrow + 16 * ds + 8 * hi);
    LAS unsigned char* qpark = lds + QPARK_OFF + (tid >> 6) * 4096 + lane * 16;
#pragma unroll
    for (int ds = NQR; ds < NDS; ++ds) *(LAS bf16x8*)(qpark + (ds - NQR) * 1024) = *(const bf16x8*)(Qrow + 16 * ds + 8 * hi);
    constexpr int K_OFF1 = K_OFF0 + 64 * KS;
    LAS float* red = (LAS float*)(lds + MISC_OFF + 1600);
    if (BIAS == 1) {
        float qn2 = 0.f;
#pragma unroll
        for (int ds = 0; ds < NQR; ++ds)
#pragma unroll
            for (int e = 0; e < 8; ++e) { const float v = __uint_as_float(((unsigned)(unsigned short)qf[ds][e]) << 16); qn2 += v * v; }
        qn2 += __shfl_xor(qn2, 32);
#pragma unroll
        for (int sh = 1; sh < 32; sh <<= 1) qn2 = fmaxf(qn2, __shfl_xor(qn2, sh));
        if (lane == 0) red[tid >> 6] = qn2;
    }
    int tlo = t_lo;
    const int t_dec = (BIAS == 1 && kn2row != nullptr && t_hi - 4 > t_lo + 1) ? t_hi - 4 : -1;
    unsigned koffB[NKC]; int kdst[NKC];
#pragma unroll
    for (int i = 0; i < NKC; ++i) {
        if (DQK == 64) { const int row = tid >> 3, ch = tid & 7; koffB[i] = (unsigned)(row * kap + ch * 8) * 2u; kdst[i] = row * KS + ch * 16; }
        else if (DQK == 192 && i == 2) { const int row = tid >> 3, ch = tid & 7; koffB[i] = (unsigned)(row * kbp + ch * 8) * 2u; kdst[i] = row * KS + (16 + ch) * 16; }
        else { const int cidx = tid + NTHREADS * i, row = cidx >> 4, ch = cidx & 15; koffB[i] = (unsigned)(row * kap + ch * 8) * 2u; kdst[i] = row * KS + ch * 16; } }
    unsigned voffB[2]; int vdst[2];
#pragma unroll
    for (int i = 0; i < 2; ++i) { const int cidx = tid + NTHREADS * i, row = cidx >> 4, ch = cidx & 15; voffB[i] = (unsigned)(row * vpp + ch * 8) * 2u; vdst[i] = row * VS + ch * 16; }
    u32x4 kreg[NKC], vreg[2];
    float m = m_io, l = l_io;
    const int koffL = l32 * KS + hi * 16;
    const int i16 = lane & 15, tq = i16 >> 2, tp = i16 & 3, blk = (lane >> 4) & 1;
    const int voffL = (4 * hi + tq) * VS + (16 * blk + 4 * tp) * 2;
    f32x16 sc0, sc1, sn0, sn1;
#define ATT_KLD(dst0, dst1, ds_) do { if ((ds_) < NDS) { dst0 = *(const LAS bf16x8*)(kq_ + (ds_) * 32); dst1 = *(const LAS bf16x8*)(kq_ + 32 * KS + (ds_) * 32); } } while (0)
#define ATT_QLD(ds_) ((ds_) < NQR ? qf[(ds_) < NQR ? (ds_) : 0] : *(const LAS bf16x8*)(qpark + ((ds_) - NQR) * 1024))
#define ATT_QK(S0, S1, kb_) do { const LAS unsigned char* kq_ = lds + ((kb_) ? K_OFF1 : K_OFF0) + koffL; \
        bf16x8 ka_[3][2]; \
        ATT_KLD(ka_[0][0], ka_[0][1], 0); ATT_KLD(ka_[1][0], ka_[1][1], 1); \
        __builtin_amdgcn_s_setprio(1); \
        _Pragma("unroll") for (int r_ = 0; r_ < 16; ++r_) { S0[r_] = 0.f; S1[r_] = 0.f; } \
        _Pragma("unroll") for (int ds_ = 0; ds_ < NDS; ++ds_) { \
            ATT_KLD(ka_[(ds_ + 2) % 3][0], ka_[(ds_ + 2) % 3][1], ds_ + 2); \
            const bf16x8 q_ = ATT_QLD(ds_); \
            S0 = MFMA32(ka_[ds_ % 3][0], q_, S0); S1 = MFMA32(ka_[ds_ % 3][1], q_, S1); \
            __builtin_amdgcn_sched_barrier(0); } __builtin_amdgcn_s_setprio(0); } while (0)
#define ATT_SMPV(S0, S1, tt_) do { \
        const int dq_ = qpos - 64 * (tt_) - 4 * hi; \
        _Pragma("unroll") for (int r_ = 0; r_ < 16; ++r_) { const int kr_ = (r_ & 3) + 8 * (r_ >> 2); \
            if (BIAS == 0) { }   \
            else if (BIAS == 1) { const float fd_ = (float)dq_; S0[r_] = S0[r_] * c - slope2 * fabsf(fd_ - (float)kr_); S1[r_] = S1[r_] * c - slope2 * fabsf(fd_ - (float)(kr_ + 32)); } \
            else { const int d0_ = dq_ - kr_; const int i0_ = min(max(d0_, -63), 256) + 63, i1_ = min(max(d0_ - 32, -63), 256) + 63; S0[r_] = S0[r_] * c + tab[i0_]; S1[r_] = S1[r_] * c + tab[i1_]; } } \
        float mx_ = fmaxf(S0[0], S1[0]); \
        _Pragma("unroll") for (int r_ = 1; r_ < 16; ++r_) mx_ = fmaxf(mx_, fmaxf(S0[r_], S1[r_])); \
        mx_ = fmaxf(mx_, __shfl_xor(mx_, 32)); \
        if (BIAS == 0) mx_ *= c; \
          \
        if (__any(mx_ - m > ATT_THR)) { const float mn2_ = fmaxf(m, mx_), alpha_ = __builtin_amdgcn_exp2f(m - mn2_); m = mn2_; l *= alpha_; \
            _Pragma("unroll") for (int d_ = 0; d_ < 4; ++d_) _Pragma("unroll") for (int r_ = 0; r_ < 16; ++r_) o[d_][r_] *= alpha_; } \
        const float mn_ = m; \
        float ps_ = 0.f; \
        _Pragma("unroll") for (int r_ = 0; r_ < 16; ++r_) { \
            if (BIAS == 0) { S0[r_] = __builtin_amdgcn_exp2f(__builtin_fmaf(S0[r_], c, -mn_)); S1[r_] = __builtin_amdgcn_exp2f(__builtin_fmaf(S1[r_], c, -mn_)); } \
            else { S0[r_] = __builtin_amdgcn_exp2f(S0[r_] - mn_); S1[r_] = __builtin_amdgcn_exp2f(S1[r_] - mn_); } \
            ps_ += S0[r_] + S1[r_]; } \
        l += ps_; \
        u32x4 pw_[4]; \
        _Pragma("unroll") for (int e_ = 0; e_ < 4; ++e_) { pw_[0][e_] = cvtpk(S0[2 * e_], S0[2 * e_ + 1]); pw_[1][e_] = cvtpk(S0[8 + 2 * e_], S0[8 + 2 * e_ + 1]); \
                                                          pw_[2][e_] = cvtpk(S1[2 * e_], S1[2 * e_ + 1]); pw_[3][e_] = cvtpk(S1[8 + 2 * e_], S1[8 + 2 * e_ + 1]); } \
        const LAS unsigned char* vb_ = lds + (((tt_) & 1) ? V_OFF1 : V_OFF0) + voffL; \
        s16x4 vl_[4], vh_[4]; \
        _Pragma("unroll") for (int i_ = 0; i_ < 3; ++i_) { vl_[i_] = vtr(vb_ + i_ * 64); vh_[i_] = vtr(vb_ + 8 * VS + i_ * 64); } \
        _Pragma("unroll") for (int i_ = 0; i_ < 16; ++i_) { const int st_ = i_ >> 2, d_ = i_ & 3; \
            if (i_ + 3 < 16) { const int s2_ = (i_ + 3) >> 2, d2_ = (i_ + 3) & 3; vl_[(i_ + 3) & 3] = vtr(vb_ + (16 * s2_) * VS + d2_ * 64); vh_[(i_ + 3) & 3] = vtr(vb_ + (16 * s2_ + 8) * VS + d2_ * 64); } \
            const bf16x8 vf_ = __builtin_shufflevector(vl_[i_ & 3], vh_[i_ & 3], 0, 1, 2, 3, 4, 5, 6, 7); \
            o[d_] = MFMA32(vf_, __builtin_bit_cast(bf16x8, pw_[st_]), o[d_]); } } while (0)
#define ATT_LOADK(t) do { _Pragma("unroll") for (int i_ = 0; i_ < NKC; ++i_) { const char* b_ = (DQK == 192 && i_ == 2) ? (const char*)(Kb + (size_t)(t) * 64 * kbp) : (const char*)(Ka + (size_t)(t) * 64 * kap); \
        kreg[i_] = *(const u32x4*)(b_ + koffB[i_]); } } while (0)
#define ATT_LOADV(t) do { const char* b_ = (const char*)(Vp + (size_t)(t) * 64 * vpp); _Pragma("unroll") for (int i_ = 0; i_ < 2; ++i_) vreg[i_] = *(const u32x4*)(b_ + voffB[i_]); } while (0)
#define ATT_STOREK(b) do { _Pragma("unroll") for (int i_ = 0; i_ < NKC; ++i_) *(LAS u32x4*)(lds + ((b) ? K_OFF1 : K_OFF0) + kdst[i_]) = kreg[i_]; } while (0)
#define ATT_STOREV(b) do { _Pragma("unroll") for (int i_ = 0; i_ < 2; ++i_) *(LAS u32x4*)(lds + ((b) ? V_OFF1 : V_OFF0) + vdst[i_]) = vreg[i_]; } while (0)
    const bool late = (__builtin_amdgcn_readfirstlane(tid >> 6) & 1) != 0;
#define ATT_ACT(tt_) (((tt_) >= wt_lo) && ((tt_) <= wt_hi))
#define ATT_SB() __builtin_amdgcn_sched_barrier(0)
    if constexpr (!AHEAD) {
        ATT_LOADK(t_hi); ATT_LOADV(t_hi); ATT_STOREK(t_hi & 1); ATT_STOREV(t_hi & 1); __syncthreads();
        for (int t = t_hi; t >= tlo; --t) {
            if (t > tlo) { ATT_LOADK(t - 1); ATT_LOADV(t - 1); }
            if (ATT_ACT(t)) { ATT_QK(sc0, sc1, t & 1); ATT_SMPV(sc0, sc1, t); }
            if (t > tlo) { ATT_STOREK((t - 1) & 1); ATT_STOREV((t - 1) & 1); }
            __syncthreads();
        }
    } else {
    ATT_LOADK(t_hi); ATT_LOADV(t_hi); ATT_STOREK(t_hi & 1); ATT_STOREV(t_hi & 1); __syncthreads();
    ATT_LOADK(t_hi - 1);
    if (ATT_ACT(t_hi)) ATT_QK(sc0, sc1, t_hi & 1);
    ATT_STOREK((t_hi - 1) & 1); __syncthreads();
    for (int t = t_hi; t > tlo; --t) {
        ATT_LOADK(max(t - 2, tlo)); ATT_LOADV(t - 1);
        ATT_SB();
        if (!late) { if (ATT_ACT(t - 1)) ATT_QK(sn0, sn1, (t - 1) & 1); }
        ATT_SB();
        if (ATT_ACT(t)) ATT_SMPV(sc0, sc1, t);
        ATT_SB();
        if (late) { if (ATT_ACT(t - 1)) ATT_QK(sn0, sn1, (t - 1) & 1); }
        ATT_SB();
        ATT_STOREK(t & 1); ATT_STOREV((t - 1) & 1);
        if (BIAS == 1) { if (t == t_dec) { float wm = m;
#pragma unroll
            for (int sh = 1; sh < 32; sh <<= 1) wm = fminf(wm, __shfl_xor(wm, sh));
            if (lane == 0) red[8 + (tid >> 6)] = wm; } }
        __syncthreads();
        if (BIAS == 1) { if (t == t_dec) {
            float qmax2 = red[0], mlo = red[8];
#pragma unroll
            for (int w = 1; w < 8; ++w) { qmax2 = fmaxf(qmax2, red[w]); mlo = fminf(mlo, red[8 + w]); }
            bool dead[2];
#pragma unroll
            for (int i = 0; i < 2; ++i) { const int tt = lane + 64 * i; const float kn2 = kn2row[tt];
                const float ub = sqrtf(qmax2 * kn2) * c * 1.001f - slope2 * (float)(q0blk - 64 * tt - 63) - mlo;
                dead[i] = (tt < t) && (ub <= -160.f); }
            const unsigned long long d0 = __ballot(dead[0]), d1 = __ballot(dead[1]);
            const int ndead = (~d0 != 0ull) ? (__ffsll((long long)~d0) - 1) : ((~d1 != 0ull) ? 64 + (__ffsll((long long)~d1) - 1) : 128);
            tlo = min(max(ndead, tlo), t - 1);
        } }
        sc0 = sn0; sc1 = sn1;
    }
    if (ATT_ACT(tlo)) ATT_SMPV(sc0, sc1, tlo);
    __syncthreads();
    }
#undef ATT_ACT
#undef ATT_SB
#undef ATT_QK
#undef ATT_KLD
#undef ATT_QLD
#undef ATT_SMPV
#undef ATT_LOADK
#undef ATT_LOADV
#undef ATT_STOREK
#undef ATT_STOREV
    m_io = m; l_io = l;
}
__device__ __forceinline__ void store_pairs(bf16* __restrict__ dst, int d, int ap, int hi, unsigned ax, unsigned ay, unsigned bx, unsigned by) {
    const auto rx = __builtin_amdgcn_permlane32_swap(ax, bx, false, false), ry = __builtin_amdgcn_permlane32_swap(ay, by, false, false);
    u32x4 w; w.x = rx[0]; w.y = ry[0]; w.z = rx[1]; w.w = ry[1];
    *(u32x4*)(dst + 32 * d + 16 * ap + 8 * hi) = w;
}
__device__ __forceinline__ void store_o(bf16* __restrict__ dst, const f32x16 (&o)[4], float inv, int hi) {
#pragma unroll
    for (int d = 0; d < 4; ++d)
#pragma unroll
        for (int ap = 0; ap < 2; ++ap) { const int r0 = 8 * ap;
            store_pairs(dst, d, ap, hi, cvtpk(o[d][r0] * inv, o[d][r0 + 1] * inv), cvtpk(o[d][r0 + 2] * inv, o[d][r0 + 3] * inv),
                                        cvtpk(o[d][r0 + 4] * inv, o[d][r0 + 5] * inv), cvtpk(o[d][r0 + 6] * inv, o[d][r0 + 7] * inv)); }
}
struct Ptrs { const bf16* proj; const bf16* qA; const bf16* kvA; bf16* mixed; const float* subln; const float* relb; const float* kn2; float lam, lam_init; };

__device__ __forceinline__ void unit_mla(LAS unsigned char* lds, const Ptrs& P, int b, int h, int qb) {
    int tid_ = threadIdx.x; asm volatile("" : "+v"(tid_));
    const int tid = tid_, lane = tid & 63, hi = lane >> 5, l32 = lane & 31, wid = __builtin_amdgcn_readfirstlane(tid >> 6);
    const size_t rowb = (size_t)b * SEQ; const int q0 = qb * 256, qrow = q0 + 32 * wid + l32;
    f32x16 o[4];
#pragma unroll
    for (int d = 0; d < 4; ++d)
#pragma unroll
        for (int r = 0; r < 16; ++r) o[d][r] = 0.f;
    float m = -1e30f, l = 0.f;
    flash_loop<192, 0, false>(lds, P.qA + (rowb + qrow) * NQ + h * 192, P.kvA + rowb * NKV + h * 256, NKV, P.proj + rowb * NINP + C_KROPE, NINP, P.kvA + rowb * NKV + h * 256 + 128, NKV,
                       0, q0 / 64 + 3, 0, q0 / 64 + (wid >> 1), 0.07216878364870323f * LOG2E, 0.f, nullptr, qrow, o, m, l);
    l += __shfl_xor(l, 32);
    store_o(P.mixed + (rowb + qrow) * DM + h * 128, o, 1.0f / l, hi);
}
__device__ __forceinline__ void unit_diff(LAS unsigned char* lds, const Ptrs& P, int b, int h, int qb) {
    int tid_ = threadIdx.x; asm volatile("" : "+v"(tid_));
    const int tid = tid_, lane = tid & 63, hi = lane >> 5, l32 = lane & 31, wid = __builtin_amdgcn_readfirstlane(tid >> 6);
    const size_t rowb = (size_t)b * SEQ; const int q0 = qb * 256, qrow = q0 + 32 * wid + l32;
    const float slope2 = exp2f(-2.0f * (float)(h + 1)) * LOG2E, c = 0.125f * LOG2E;
    const bf16* qp = P.proj + (rowb + qrow) * NINP + C_QB + h * 128; const bf16* kp = P.proj + rowb * NINP + C_KB + h * 128; const bf16* vp = P.proj + rowb * NINP + C_VB + h * 128;
    const int t_hi = q0 / 64 + 3, wt_hi = q0 / 64 + (wid >> 1);
    f32x16 o[4];
#pragma unroll
    for (int d = 0; d < 4; ++d)
#pragma unroll
        for (int r = 0; r < 16; ++r) o[d][r] = 0.f;
    float m = -1e30f, l = 0.f;
    const float* kn2 = P.kn2 + ((b * 4 + h) * 2) * 128;
    flash_loop<64, 1>(lds, qp + 64, kp + 64, NINP, kp, NINP, vp, NINP, 0, t_hi, 0, wt_hi, c, slope2, nullptr, qrow, o, m, l, kn2 + 128, q0);
    l += __shfl_xor(l, 32);
    LAS unsigned* stash = (LAS unsigned*)(lds + STASH_OFF) + tid;
    { const float f = P.lam / l;
#pragma unroll
      for (int d = 0; d < 4; ++d)
#pragma unroll
          for (int e = 0; e < 8; ++e) { stash[(d * 8 + e) * NTHREADS] = cvtpk(o[d][2 * e] * f, o[d][2 * e + 1] * f); o[d][2 * e] = 0.f; o[d][2 * e + 1] = 0.f; } }
    m = -1e30f; l = 0.f;
    flash_loop<64, 1>(lds, qp, kp, NINP, kp, NINP, vp, NINP, 0, t_hi, 0, wt_hi, c, slope2, nullptr, qrow, o, m, l, kn2, q0);
    l += __shfl_xor(l, 32);
    const float inv = 1.0f / l; float ss = 0.f;
#pragma unroll
    for (int d = 0; d < 4; ++d)
#pragma unroll
        for (int e = 0; e < 8; ++e) { const unsigned w = stash[(d * 8 + e) * NTHREADS];
            const float v0 = o[d][2 * e] * inv - __uint_as_float(w << 16), v1 = o[d][2 * e + 1] * inv - __uint_as_float(w & 0xffff0000u);
            o[d][2 * e] = v0; o[d][2 * e + 1] = v1; ss += v0 * v0 + v1 * v1; }
    ss += __shfl_xor(ss, 32);
    const float rs = (1.0f / sqrtf(ss * (1.f / 128.f) + EPS)) * (1.0f - P.lam_init);
    bf16* dst = P.mixed + (rowb + qrow) * DM + 1024 + h * 128;
#pragma unroll
    for (int d = 0; d < 4; ++d)
#pragma unroll
        for (int ap = 0; ap < 2; ++ap) { const int r0 = 8 * ap;
            const f32x4 g0 = *(const f32x4*)(P.subln + 32 * d + 16 * ap + 4 * hi), g1 = *(const f32x4*)(P.subln + 32 * d + 16 * ap + 8 + 4 * hi);
            store_pairs(dst, d, ap, hi, cvtpk(o[d][r0] * rs * g0[0], o[d][r0 + 1] * rs * g0[1]), cvtpk(o[d][r0 + 2] * rs * g0[2], o[d][r0 + 3] * rs * g0[3]),
                                        cvtpk(o[d][r0 + 4] * rs * g1[0], o[d][r0 + 5] * rs * g1[1]), cvtpk(o[d][r0 + 6] * rs * g1[2], o[d][r0 + 7] * rs * g1[3])); }
}
__device__ __forceinline__ void unit_band(LAS unsigned char* lds, const Ptrs& P, int b, int h, int qb) {
    int tid_ = threadIdx.x; asm volatile("" : "+v"(tid_));
    const int tid = tid_, lane = tid & 63, hi = lane >> 5, l32 = lane & 31, wid = __builtin_amdgcn_readfirstlane(tid >> 6);
    const size_t rowb = (size_t)b * SEQ; const int q0 = qb * 256, qrow = q0 + 32 * wid + l32;
    LAS float* tab = (LAS float*)(lds + MISC_OFF + 256);
    if (tid < 320) tab[tid] = P.relb[h * 320 + tid] * LOG2E;
    const int c0 = q0 / 64, cw = c0 + (wid >> 1);
    f32x16 o[4];
#pragma unroll
    for (int d = 0; d < 4; ++d)
#pragma unroll
        for (int r = 0; r < 16; ++r) o[d][r] = 0.f;
    float m = -1e30f, l = 0.f;
    const bf16* kp = P.proj + rowb * NINP + C_KC + h * 128;
    flash_loop<128, 2>(lds, P.proj + (rowb + qrow) * NINP + C_QC + h * 128, kp, NINP, kp, NINP, P.proj + rowb * NINP + C_VC + h * 128, NINP,
                       max(c0 - 8, 0), c0 + 3, max(cw - 8, 0), cw, 0.08838834764831845f * LOG2E, 0.f, tab, qrow, o, m, l);
    l += __shfl_xor(l, 32);
    store_o(P.mixed + (rowb + qrow) * DM + 1536 + h * 128, o, 1.0f / l, hi);
}
__device__ __forceinline__ int next_item(volatile LAS int* s_item, unsigned* ctr) {
    if (threadIdx.x == 0) *s_item = (int)atomicAdd(ctr, 1u);
    __syncthreads();
    const int item = __builtin_amdgcn_readfirstlane(*s_item);
    __syncthreads();
    return item;
}
__device__ __forceinline__ void attention_phase(LAS unsigned char* lds, const Ptrs& P, unsigned* ctr, int n_conv) {
    volatile LAS int* s_item = (volatile LAS int*)(lds + MISC_OFF);
    const int n_groups = n_conv > 0 ? 128 : 0, n_mixed = n_groups * 13;
    for (;;) {
        const int e = next_item(s_item, ctr);
        int item;
        if (e < n_mixed) { const int g = e / 13, r = e - g * 13;
            if (r >= 8) {
                int tid_ = threadIdx.x; asm volatile("" : "+v"(tid_));
                const int lane = tid_ & 63, wave = __builtin_amdgcn_readfirstlane(tid_ >> 6); LAS float* scr = (LAS float*)(lds + wave * 16384);
                const int c = 5 * g + (r - 8); unsigned char* ws = arg_ws();
                if (c < n_conv) {
#pragma unroll 1
                    for (int k = 0; k < CONV_CHUNK / NWAVES; ++k) { const int d = CONV_CHUNK * c + wave + NWAVES * k;
                        if (d < N_DEFER) { if (d < I_LAYER - I_EARLY) convert_item(0, I_EARLY + d, ws, scr, lane); else { const int d1 = d - (I_LAYER - I_EARLY); convert_item(d1 / I_LAYER + 1, d1 % I_LAYER, ws, scr, lane); } } }
                }
                continue;
            }
            item = 8 * g + r;
        } else item = e - n_mixed + 8 * n_groups;
        if (item >= 1024) break;
        if (item >= 696 && item < 952) { const int ci = item - 696; unit_band(lds, P, (ci >> 2) & 1, ci & 3, ci >> 3); }
        else { const int idx = item < 696 ? item : item - 256; const int qb = 31 - idx / 24, j = idx % 24;
            if (j < 16) unit_mla(lds, P, j >> 3, j & 7, qb); else unit_diff(lds, P, (j - 16) >> 2, (j - 16) & 3, qb); }
    }
}
#undef MFMA32
}
#define XB_TMO      128
#define XB_XCNT(j)  (256  + 64 * (j))
#define XB_XSUB(j)  (1280 + 64 * (j))
#define XB_XGEN(j)  (2304 + 64 * (j))
#define XB_TOP      3328
#define XB_TOPGEN   3392
#define XCD_BAR_WORDS 3456
#define XB_SPIN_CAP (1u << 18)

__device__ __forceinline__ unsigned xb_ld(unsigned* p)              { return __hip_atomic_load(p, __ATOMIC_RELAXED, __HIP_MEMORY_SCOPE_AGENT); }
__device__ __forceinline__ unsigned xb_add(unsigned* p, unsigned v) { return __hip_atomic_fetch_add(p, v, __ATOMIC_RELAXED, __HIP_MEMORY_SCOPE_AGENT); }
__device__ __forceinline__ unsigned xb_xcc_id() { return (unsigned)__builtin_amdgcn_s_getreg((3 << 11) | 20) & 0xFu; }
#define XB_SPIN(cond, bar) do { unsigned _sp = 0; while (cond) { __builtin_amdgcn_s_sleep(1); \
    if ((++_sp & 255u) == 0u) { if (xb_ld(&(bar)[XB_TMO])) break; if (_sp > XB_SPIN_CAP) { atomicAdd(&(bar)[XB_TMO], 1u); break; } } } } while (0)

struct XcdBarrier {
    unsigned* bar; unsigned x;
    volatile LAS unsigned* st;
};

__device__ __forceinline__ XcdBarrier xcd_barrier_post(unsigned* bar, volatile LAS unsigned* st) {
    XcdBarrier b; b.bar = bar; b.x = xb_xcc_id(); b.st = st;
    if (threadIdx.x == 0) (void)xb_add(&bar[XB_XCNT(b.x)], 1u);
    return b;
}
__device__ __forceinline__ void xcd_barrier_complete(unsigned* bar, unsigned x, unsigned& nloc, unsigned& nx) {
    const unsigned G = gridDim.x * gridDim.y * gridDim.z;
    unsigned sum, cnt, mine, sp = 0u;
    for (;;) {
        sum = 0u; cnt = 0u; mine = 0u;
#pragma unroll
        for (unsigned j = 0; j < 16; ++j) { const unsigned c = xb_ld(&bar[XB_XCNT(j)]); sum += c; cnt += (c > 0u) ? 1u : 0u; mine = (j == x) ? c : mine; }
        if (sum == G) break;
        __builtin_amdgcn_s_sleep(1);
        if ((++sp & 255u) == 0u) { if (xb_ld(&bar[XB_TMO])) break; if (sp > XB_SPIN_CAP) { atomicAdd(&bar[XB_TMO], 1u); break; } }
    }
    nloc = mine > 0u ? mine : 1u; nx = cnt > 0u ? cnt : 1u;
}

__device__ __forceinline__ void xcd_barrier(const XcdBarrier& b) {
    asm volatile("s_waitcnt vmcnt(0)" ::: "memory");
    __syncthreads();
    if (threadIdx.x == 0) {
        unsigned* bar = b.bar; asm volatile("" : "+s"(bar)); unsigned bx = b.x; asm volatile("" : "+s"(bx));
        __builtin_amdgcn_s_waitcnt(0);
        unsigned nloc = b.st[0], nx = b.st[1];
        if (nloc == 0u) { xcd_barrier_complete(bar, bx, nloc, nx); b.st[0] = nloc; b.st[1] = nx; }
        const unsigned old = xb_add(&bar[XB_XSUB(bx)], 1u);
        const unsigned gen = old / nloc;
        if (old + 1u == (gen + 1u) * nloc) {
            __builtin_amdgcn_fence(__ATOMIC_RELEASE, "agent");
            asm volatile("s_waitcnt vmcnt(0)" ::: "memory");
            const unsigned og = xb_add(&bar[XB_TOP], 1u);
            const unsigned tg = og / nx;
            if (og + 1u == (tg + 1u) * nx) xb_add(&bar[XB_TOPGEN], 1u);
            else XB_SPIN(xb_ld(&bar[XB_TOPGEN]) == tg, bar);
            __builtin_amdgcn_fence(__ATOMIC_ACQUIRE, "agent");
            xb_add(&bar[XB_XGEN(bx)], 1u);
            asm volatile("s_waitcnt vmcnt(0)" ::: "memory");
        } else {
            XB_SPIN(xb_ld(&bar[XB_XGEN(bx)]) == gen, bar);
            __builtin_amdgcn_fence(__ATOMIC_ACQUIRE, "agent");
            asm volatile("s_waitcnt vmcnt(0)" ::: "memory");
        }
    }
    __syncthreads();
}

struct Args { const float* in[18]; float* out; unsigned char* ws; int ph_lo, ph_hi; };
constexpr int N_PHASES = 2 + 6 * DEPTH;

__global__ void __launch_bounds__(NTHREADS, 2) fwd_mega(Args a) {
    extern __shared__ __attribute__((aligned(16))) unsigned char lds_raw[];
    LAS unsigned char* lds = (LAS unsigned char*)lds_raw;
    cg::grid_group grid = cg::this_grid();
    const int G = gridDim.x;
    unsigned char* ws = a.ws;
    float* xres = a.out;
    bf16* hn = (bf16*)(ws + WS_HN); bf16* proj = (bf16*)a.out;        bf16* qA = (bf16*)(ws + WS_QA); bf16* kvA = (bf16*)(ws + WS_KVA); bf16* hff = (bf16*)(ws + WS_HFF);
    bf16* xb = (bf16*)(ws + WS_XB); float* part = (float*)(ws + WS_PART);
    float* rope_tab = (float*)(ws + WS_ROPE);
    unsigned* ctl = (unsigned*)(ws + WS_CTL);
    const int lo = a.ph_lo, hi = a.ph_hi;
    if (threadIdx.x < 2) ((volatile LAS unsigned*)(lds + MISC_OFF + 64))[threadIdx.x] = 0u;
    __syncthreads();
    XcdBarrier xbar = xcd_barrier_post(ctl + CW_BAR, (volatile LAS unsigned*)(lds + MISC_OFF + 64));
#ifndef PH_MASK
#define PH_MASK 0x3ff
#endif
#define PH_BEGIN(k) if (((PH_MASK >> PH_SUB) & 1) && lo <= (k) && (k) < hi) { \
        int tid_ = threadIdx.x; asm volatile("" : "+v"(tid_));        \
        int bid_ = blockIdx.x, Go_ = G; asm volatile("" : "+s"(bid_), "+s"(Go_));        \
        const int bid = bid_, Gp = Go_; \
        const int tid = tid_, lane = tid & 63, wave = __builtin_amdgcn_readfirstlane(tid >> 6), gw = bid * NWAVES + wave, ngw = Gp * NWAVES; (void)lane; (void)gw; (void)ngw; (void)tid;
#define PH_END(k) } if (lo <= (k) && (k) + 1 < hi) { if (lo < 0) grid.sync(); else xcd_barrier(xbar); }

#define PH_SUB 9
    PH_BEGIN(0)
#undef PH_SUB
        LAS float* scr = (LAS float*)(lds + wave * 16384);
        for (int it = gw; it < I_EARLY; it += ngw) convert_item(0, it, ws, scr, lane);
        {
            const int gt = blockIdx.x * NTHREADS + tid, ngt = G * NTHREADS;
            constexpr int PADV = (NINP - NIN) * DM * 2 / 16;
            for (int i = gt; i < DEPTH * PADV; i += ngt) { const int l = i / PADV, r = i - l * PADV;
                ((u32x4*)(ws + WS_W + (size_t)l * W_LAYER + WO_IN + (size_t)NIN * DM * 2))[r] = (u32x4){0u, 0u, 0u, 0u}; }
            for (int i = gt; i < SEQ * 32; i += ngt) { const int pos = i >> 5, fi = i & 31;
                double f = 1.0; for (int k = 0; k < fi; ++k) f *= 0.74989420933245582;
                const float inv_freq = (float)f, ang = (float)pos * inv_freq;
                double rev = (double)ang * 0.15915494309189535; rev -= __builtin_rint(rev);
                const float rv = (float)rev;
                ((f32x2_t*)rope_tab)[i] = (f32x2_t){__builtin_amdgcn_cosf(rv), __builtin_amdgcn_sinf(rv)}; }
        }
        xb_rows_phase(arg_in(0), xb, part, gw, ngw, lane);
    PH_END(0)

    LAS float* rs0 = (LAS float*)(lds + MISC_OFF + 2048);
    LAS float* rs1 = rs0 + 256;
#pragma unroll 1
    for (int l = 0; l < DEPTH; ++l) {
        const int pb = 1 + 6 * l;
        unsigned char* wl = ws + WS_W + (size_t)l * W_LAYER;
#define PH_SUB 0
        PH_BEGIN(pb + 0)
#undef PH_SUB
            pg8::Gemm g{xb, (const bf16*)(wl + WO_IN), M, NINP, DM, DM}; pg8::StaticOrder S; S.init(M, NINP, Gp, bid);
            { pg8::Unit u0; S.next(0, u0); panel_rstd_from_part(part, u0.pm, rs0, tid); }
            pg8::EpiBf<0, true> E{proj, NINP, 1 << 20, C_KROPE, rope_tab, rs0};
            pg8::gemm_phase<pg8::EpiBf<0, true>, pg8::StaticOrder, true, true>(lds, g, S, E);
        PH_END(pb + 0)
#define PH_SUB 1
        PH_BEGIN(pb + 1)
#undef PH_SUB
            { pg8::Gemm g{proj, (const bf16*)(wl + WO_UQ), M, NQ, QR, NINP}; pg8::StaticOrder S; S.init(M, NQ, Gp, bid);
              { pg8::Unit u0; S.next(0, u0); panel_rstd_cqkv(proj, u0.pm, rs0, rs1, wave, lane); }
              pg8::EpiBf<0, true> E{qA, NQ, 192, 128, rope_tab, rs0};
              pg8::gemm_phase<pg8::EpiBf<0, true>, pg8::StaticOrder, true, true>(lds, g, S, E); }
            { pg8::Gemm g{proj + QR, (const bf16*)(wl + WO_UKV), M, NKV, KVR, NINP}; pg8::StaticOrder S; S.init(M, NKV, Gp, bid);
              pg8::EpiBf<0, false> E{kvA, NKV, 1, 0, nullptr, rs1};
              pg8::gemm_phase<pg8::EpiBf<0, false>, pg8::StaticOrder, true, true>(lds, g, S, E); }
            {
                float* kn2 = (float*)(ws + WS_CTL + 65536);
                for (int it = gw; it < 2048; it += ngw) { const int bb = it >> 10, hh = (it >> 8) & 3, mp = (it >> 7) & 1, tt = it & 127;
                    const u32x4* kp = (const u32x4*)(proj + ((size_t)bb * SEQ + 64 * tt + lane) * NINP + C_KB + hh * 128 + mp * 64);
                    float sq = 0.f;
#pragma unroll
                    for (int j = 0; j < 8; ++j) { const u32x4 w = kp[j];
#pragma unroll
                        for (int e = 0; e < 4; ++e) { const float f0 = __uint_as_float(w[e] << 16), f1 = __uint_as_float(w[e] & 0xffff0000u); sq += f0 * f0 + f1 * f1; } }
#pragma unroll
                    for (int sh = 1; sh < 64; sh <<= 1) sq = fmaxf(sq, __shfl_xor(sq, sh));
                    if (lane == 0) kn2[it] = sq; }
            }
        PH_END(pb + 1)
#define PH_SUB 2
        PH_BEGIN(pb + 2)
#undef PH_SUB
            att::Ptrs P; P.proj = proj; P.qA = qA; P.kvA = kvA; P.mixed = hn; P.subln = arg_in(11) + l * 128; P.relb = arg_in(12) + l * 4 * 320; P.kn2 = (const float*)(ws + WS_CTL + 65536);
            { const float s1 = wave_sum(arg_in(7)[l * 64 + lane] * arg_in(8)[l * 64 + lane]), s2 = wave_sum(arg_in(9)[l * 64 + lane] * arg_in(10)[l * 64 + lane]);
              P.lam_init = 0.8f - 0.6f * expf(-0.3f * (float)l); P.lam = expf(s1) - expf(s2) + P.lam_init; }
            att::attention_phase(lds, P, ctl + 64 * l, l == 0 ? N_CONV_CHUNKS : 0);
        PH_END(pb + 2)
#define PH_SUB 3
        PH_BEGIN(pb + 3)
#undef PH_SUB
            pg8::Gemm g{hn, (const bf16*)(wl + WO_O), M, DM, DM, DM}; pg8::StaticOrder S; S.init(M, DM, Gp, bid);
            pg8::EpiRes E{xb, part, DM};
            pg8::gemm_phase<pg8::EpiRes, pg8::StaticOrder, true, true>(lds, g, S, E);
        PH_END(pb + 3)
#define PH_SUB 4
        PH_BEGIN(pb + 4)
#undef PH_SUB
            pg8::Gemm g{xb, (const bf16*)(wl + WO_UP), M, DFF, DM, DM}; pg8::StaticOrder S; S.init(M, DFF, Gp, bid);
            { pg8::Unit u0; S.next(0, u0); panel_rstd_from_part(part, u0.pm, rs0, tid); }
            pg8::EpiBf<2, false> E{hff, DFF, 1, 0, nullptr, rs0};
            pg8::gemm_phase<pg8::EpiBf<2, false>, pg8::StaticOrder, true, true>(lds, g, S, E);
        PH_END(pb + 4)
#define PH_SUB 5
        PH_BEGIN(pb + 5)
#undef PH_SUB
            pg8::Gemm g{hff, (const bf16*)(wl + WO_DN), M, DM, DFF, DFF}; pg8::StaticOrder S; S.init(M, DM, Gp, bid);
            pg8::EpiRes E{xb, part, DM};
            pg8::gemm_phase<pg8::EpiRes, pg8::StaticOrder, true, true>(lds, g, S, E);
        PH_END(pb + 5)
    }
#define PH_SUB 6
    PH_BEGIN(N_PHASES - 1)
#undef PH_SUB
        final_norm_phase(xb, xres, arg_in(17), gw, ngw, lane);
    PH_END(N_PHASES - 1)
#undef PH_BEGIN
#undef PH_END
}

#ifndef MK_PER_PHASE
#define MK_PER_PHASE 0
#endif
extern "C" void kernel_launch(void* const* d_in, const int* in_sizes, int n_in, void* d_out, int out_size, void* d_ws, size_t ws_size, hipStream_t stream) {
    static int grid = 0;
    if (grid == 0) {
        if (n_in != 18 || out_size != M * DM || ws_size < WS_END) { fprintf(stderr, "kernel_launch: unexpected problem (n_in %d out %d ws %zu)\n", n_in, out_size, ws_size); grid = -1; return; }
        int dev = 0, cus = 0, per_cu = 0;
        (void)hipGetDevice(&dev); (void)hipDeviceGetAttribute(&cus, hipDeviceAttributeMultiprocessorCount, dev);
        if (hipFuncSetAttribute((const void*)fwd_mega, hipFuncAttributeMaxDynamicSharedMemorySize, LDS_BYTES) != hipSuccess) { fprintf(stderr, "kernel_launch: hipFuncSetAttribute failed\n"); grid = -1; return; }
        if (hipOccupancyMaxActiveBlocksPerMultiprocessor(&per_cu, (const void*)fwd_mega, NTHREADS, LDS_BYTES) != hipSuccess || per_cu < 1) per_cu = 1;
        (void)hipGetLastError();
        grid = cus * per_cu; if (grid <= 0) grid = 256;
    }
    if (grid < 0) return;
    (void)hipMemsetAsync((char*)d_ws + WS_CTL, 0, 32768, stream);
    Args a{};
    for (int i = 0; i < 18; ++i) a.in[i] = (const float*)d_in[i];
    a.out = (float*)d_out; a.ws = (unsigned char*)d_ws;
#if MK_PER_PHASE
    for (int p = 0; p < N_PHASES; ++p) { a.ph_lo = p; a.ph_hi = p + 1; hipLaunchKernelGGL(fwd_mega, dim3(grid), dim3(NTHREADS), LDS_BYTES, stream, a); }
#else
    a.ph_lo = 0; a.ph_hi = N_PHASES;
    void* args[] = {&a};
    hipError_t e = hipLaunchCooperativeKernel((const void*)fwd_mega, dim3(grid), dim3(NTHREADS), args, LDS_BYTES, stream);
    if (e != hipSuccess) fprintf(stderr, "kernel_launch: cooperative launch failed: %s (grid %d)\n", hipGetErrorString(e), grid);
#endif
}
```

```cpp
#include <hip/hip_runtime.h>
#include <hip/hip_cooperative_groups.h>
#include <cstdio>
#include <cstdint>
namespace cg = cooperative_groups;
namespace pg8 {
#define PG8_LAS __attribute__((address_space(3)))
typedef unsigned short bf16_t;
typedef short bf16x8 __attribute__((ext_vector_type(8)));
typedef float f32x4 __attribute__((ext_vector_type(4)));
typedef unsigned u32x4 __attribute__((ext_vector_type(4)));
constexpr int BM = 256, BK = 64, HALF = 128, HTB = HALF * BK * 2  , STAGE_BYTES = 8 * HTB, NXCD = 8, WGM = 8;

__host__ __device__ __forceinline__ int lds_byte(int r, int c) { const int st = (r >> 4) * 2 + (c >> 5), rr = r & 15, cc = c & 31, ob = rr * 64 + cc * 2; return st * 1024 + (ob ^ (((ob >> 9) & 1) << 5)); }
__host__ __device__ __forceinline__ void stage_rc(int b, int& R, int& C) { const int st = b / 1024, sb = b % 1024, swz = sb ^ (((sb >> 9) & 1) << 5); R = (st >> 1) * 16 + swz / 64; C = (st & 1) * 32 + (swz % 64) / 2; }
__host__ __device__ __forceinline__ int perm32(int rho) { const int n = rho >> 4, i = rho & 15; return 8 * (i >> 2) + 4 * n + (i & 3); }

struct Unit { int pm, pn; };
struct Gemm { const bf16_t* A; const bf16_t* Bt; int M, N, K, lda; };

struct StaticOrder {
    int nM, nN, nwg, G, c;
    __host__ __device__ void init(int M, int N, int G_, int c_) { nM = M / BM; nN = N / BM; nwg = nM * nN; G = G_; c = c_; }
    __host__ __device__ bool next(int i, Unit& u) const {
        const long L = (long)i * G + c; if (L >= nwg) return false;
        int wgid = (int)L; { const int q = nwg / NXCD, r = nwg % NXCD, xcd = wgid % NXCD, off = wgid / NXCD; wgid = (xcd < r ? xcd * (q + 1) : r * (q + 1) + (xcd - r) * q) + off; }
        const int nig = WGM * nN, gid = wgid / nig, fm = gid * WGM, gsz = (nM - fm) < WGM ? (nM - fm) : WGM;
        u.pm = fm + ((wgid % nig) % gsz); u.pn = (wgid % nig) / gsz; return true;
    }
    __device__ __forceinline__ void a_ready(const Unit&) const {}
    __device__ __forceinline__ void done(const Unit&) const {}
};

__device__ __forceinline__ unsigned cvt_pk_bf16(float lo, float hi) { unsigned r; asm volatile("v_cvt_pk_bf16_f32 %0, %1, %2" : "=v"(r) : "v"(lo), "v"(hi)); return r; }
typedef float f32x2 __attribute__((ext_vector_type(2)));
template <int ACT, bool ROPE> struct EpiBf {
    static constexpr bool PERM = true, AFTER_DRAIN = false;
    bf16_t* O; int ldc; int rope_period, rope_start; const float* rope_tab; const PG8_LAS float* rs;
    __device__ __forceinline__ void operator()(const f32x4 (&acc)[2][2][4][2], const Unit& u, int wr, int wc, int fr, int fq) const {
        const int row0 = u.pm * BM + wr * 64 + fr; const int colw = u.pn * BM + wc * 32; const int col0 = colw + 8 * fq;
#pragma unroll
        for (int bj = 0; bj < 2; ++bj) {
            bool rope = false; int pair0 = 0;
            if (ROPE) { const int sec = (colw + bj * HALF) % rope_period; rope = (sec >= rope_start) && (sec < rope_start + 64); pair0 = ((sec - rope_start) >> 1) + 4 * fq; }
#pragma unroll
            for (int ai = 0; ai < 2; ++ai)
#pragma unroll
                for (int m = 0; m < 4; ++m) {
                    const int row = row0 + ai * HALF + m * 16;
                    const float rsc = rs[wr * 64 + fr + ai * HALF + m * 16];
                    f32x4 v0 = acc[ai][bj][m][0] * rsc, v1 = acc[ai][bj][m][1] * rsc;
                    if (ACT == 2) {
#pragma unroll
                        for (int e = 0; e < 4; ++e) { const float a = fmaxf(v0[e], 0.f), b = fmaxf(v1[e], 0.f); v0[e] = a * a; v1[e] = b * b; }
                    }
                    if (ROPE) { if (rope) {
                        const float* tp = rope_tab + ((size_t)(row & 8191) * 32 + pair0) * 2;
                        const f32x4 t0 = *(const f32x4*)tp, t1 = *(const f32x4*)(tp + 4);
                        f32x4 r0, r1;
                        r0[0] = v0[0] * t0[0] - v0[1] * t0[1]; r0[1] = v0[1] * t0[0] + v0[0] * t0[1];
                        r0[2] = v0[2] * t0[2] - v0[3] * t0[3]; r0[3] = v0[3] * t0[2] + v0[2] * t0[3];
                        r1[0] = v1[0] * t1[0] - v1[1] * t1[1]; r1[1] = v1[1] * t1[0] + v1[0] * t1[1];
                        r1[2] = v1[2] * t1[2] - v1[3] * t1[3]; r1[3] = v1[3] * t1[2] + v1[2] * t1[3];
                        v0 = r0; v1 = r1; } }
                    u32x4 w; w.x = cvt_pk_bf16(v0[0], v0[1]); w.y = cvt_pk_bf16(v0[2], v0[3]); w.z = cvt_pk_bf16(v1[0], v1[1]); w.w = cvt_pk_bf16(v1[2], v1[3]);
                    *(u32x4*)(O + (size_t)row * ldc + col0 + bj * HALF) = w;
                }
        }
    }
};
struct EpiRes {
    static constexpr bool PERM = true, AFTER_DRAIN = false;
    bf16_t* xb; float* part; int ldc;
    __device__ __forceinline__ void operator()(const f32x4 (&acc)[2][2][4][2], const Unit& u, int wr, int wc, int fr, int fq) const {
        const int col0 = u.pn * BM + wc * 32 + 8 * fq;
#pragma unroll
        for (int ai = 0; ai < 2; ++ai)
#pragma unroll
            for (int m = 0; m < 4; ++m) { const int row = u.pm * BM + ai * HALF + wr * 64 + m * 16 + fr; const size_t off = (size_t)row * ldc + col0;
                u32x4 bs[2];
#pragma unroll
                for (int bj = 0; bj < 2; ++bj) bs[bj] = *(const u32x4*)(xb + off + bj * HALF);
                float ss = 0.f;
#pragma unroll
                for (int bj = 0; bj < 2; ++bj) { const u32x4 b = bs[bj]; const f32x4 a0 = acc[ai][bj][m][0], a1 = acc[ai][bj][m][1];
                    const float o0 = __uint_as_float(b.x << 16) + a0[0], o1 = __uint_as_float(b.x & 0xffff0000u) + a0[1], o2 = __uint_as_float(b.y << 16) + a0[2], o3 = __uint_as_float(b.y & 0xffff0000u) + a0[3];
                    const float o4 = __uint_as_float(b.z << 16) + a1[0], o5 = __uint_as_float(b.z & 0xffff0000u) + a1[1], o6 = __uint_as_float(b.w << 16) + a1[2], o7 = __uint_as_float(b.w & 0xffff0000u) + a1[3];
                    ss += ((o0 * o0 + o1 * o1) + (o2 * o2 + o3 * o3)) + ((o4 * o4 + o5 * o5) + (o6 * o6 + o7 * o7));
                    u32x4 w; w.x = cvt_pk_bf16(o0, o1); w.y = cvt_pk_bf16(o2, o3); w.z = cvt_pk_bf16(o4, o5); w.w = cvt_pk_bf16(o6, o7);
                    *(u32x4*)(xb + off + bj * HALF) = w; }
                ss += __shfl_xor(ss, 16); ss += __shfl_xor(ss, 32);
                if (fq == 0) part[(size_t)row * 32 + u.pn * 4 + wc] = ss;
            }
    }
};
template <class Epi, class Sched, bool ALIGN_EPI = false, bool SP2 = false>
__device__ __forceinline__ void gemm_phase(PG8_LAS unsigned char* lds, const Gemm g, const Sched& S, const Epi& E) {
    int tid_ = threadIdx.x; asm volatile("" : "+v"(tid_));
    const int tid = tid_, wid = __builtin_amdgcn_readfirstlane(tid >> 6), lane = tid & 63, wr = wid >> 2, wc = wid & 3, fr = lane & 15, fq = lane >> 4;
    int K_ = g.K, lda_ = g.lda; asm volatile("" : "+s"(K_), "+s"(lda_));
    const int K = K_, nt = K / BK, LDA = lda_;
    unsigned voffA[2], voffB[2];
#pragma unroll
    for (int i = 0; i < 2; ++i) { int R, C; stage_rc(tid * 16 + i * 8192, R, C); const int Rb = Epi::PERM ? ((R & ~31) + perm32(R & 31)) : R;
        voffA[i] = (unsigned)(R * LDA + C) * 2u; voffB[i] = (unsigned)(Rb * K + C) * 2u; }
    const size_t kstep = (size_t)(BK * 2);
    const size_t hstep = (size_t)HALF * K * 2;
    const size_t tstep = 2 * hstep; const size_t hstepA = (size_t)HALF * LDA * 2, tstepA = 2 * hstepA;
    const unsigned ldsw = (unsigned)wid * 1024u;
    const int aoff = lds_byte(wr * 64 + fr, fq * 8), boff = lds_byte(wc * 32 + fr, fq * 8);
#define PG8_SA(b, h) (((b) * 2 + (h)) * HTB)
#define PG8_SB(b, h) ((4 + (b) * 2 + (h)) * HTB)
#define PG8_STAGE(bufoff, gbase, voff) do { _Pragma("unroll") for (int _i = 0; _i < 2; ++_i) \
        __builtin_amdgcn_global_load_lds((const unsigned*)((const char*)(gbase) + (voff)[_i]), (PG8_LAS unsigned*)(lds + (bufoff) + ldsw + _i * 8192), 16, 0, 0); } while (0)
#define PG8_LDA(dst, b, h) do { _Pragma("unroll") for (int m = 0; m < 4; ++m) _Pragma("unroll") for (int k = 0; k < 2; ++k) dst[m][k] = *(const PG8_LAS bf16x8*)(lds + PG8_SA(b, h) + aoff + m * 2048 + k * 1024); } while (0)
#define PG8_LDB(dst, b, h) do { _Pragma("unroll") for (int n = 0; n < 2; ++n) _Pragma("unroll") for (int k = 0; k < 2; ++k) dst[n][k] = *(const PG8_LAS bf16x8*)(lds + PG8_SB(b, h) + boff + n * 2048 + k * 1024); } while (0)
#define PG8_MMA(ai, bj, At, Bt) do { __builtin_amdgcn_s_setprio(1); _Pragma("unroll") for (int m = 0; m < 4; ++m) _Pragma("unroll") for (int n = 0; n < 2; ++n) _Pragma("unroll") for (int k = 0; k < 2; ++k) \
        acc[ai][bj][m][n] = __builtin_amdgcn_mfma_f32_16x16x32_bf16(Bt[n][k], At[m][k], acc[ai][bj][m][n], 0, 0, 0); __builtin_amdgcn_s_setprio(0); } while (0)
#define PG8_WAIT_V(n) asm volatile("s_waitcnt vmcnt(" #n ")" ::: "memory")
#define PG8_WAIT_L(n) asm volatile("s_waitcnt lgkmcnt(" #n ")" ::: "memory")
#define PG8_BAR __builtin_amdgcn_s_barrier()
#define PG8_SCHED __builtin_amdgcn_sched_barrier(0)
    Unit cur, nxt; int ui = 0;
    if (!S.next(0, cur)) return;
    f32x4 acc[2][2][4][2];
#pragma unroll
    for (int a = 0; a < 2; ++a)
#pragma unroll
        for (int b = 0; b < 2; ++b)
#pragma unroll
            for (int m = 0; m < 4; ++m)
#pragma unroll
                for (int n = 0; n < 2; ++n) acc[a][b][m][n] = (f32x4){0.f, 0.f, 0.f, 0.f};
    bf16x8 At[4][2], B0[2][2], B1[2][2];
    const char* cA = (const char*)g.A + (size_t)cur.pm * tstepA; const char* cB = (const char*)g.Bt + (size_t)cur.pn * tstep;
    S.a_ready(cur);
    if constexpr (SP2) {
        PG8_STAGE(PG8_SB(0, 0), cB, voffB); PG8_STAGE(PG8_SB(0, 1), cB + hstep, voffB); PG8_STAGE(PG8_SA(0, 0), cA, voffA); PG8_STAGE(PG8_SA(0, 1), cA + hstepA, voffA);
        if (wr == 1) PG8_BAR;
        PG8_WAIT_V(2); PG8_BAR;
        PG8_STAGE(PG8_SB(1, 0), cB + kstep, voffB); PG8_STAGE(PG8_SA(1, 0), cA + kstep, voffA); PG8_STAGE(PG8_SB(1, 1), cB + hstep + kstep, voffB);
        PG8_WAIT_V(6); PG8_BAR;
    } else {
        PG8_STAGE(PG8_SB(0, 0), cB, voffB); PG8_STAGE(PG8_SA(0, 0), cA, voffA); PG8_STAGE(PG8_SB(0, 1), cB + hstep, voffB); PG8_STAGE(PG8_SA(0, 1), cA + hstepA, voffA);
        if (wr == 1) PG8_BAR;
        PG8_WAIT_V(4); PG8_BAR;
        PG8_STAGE(PG8_SB(1, 0), cB + kstep, voffB); PG8_STAGE(PG8_SA(1, 0), cA + kstep, voffA); PG8_STAGE(PG8_SB(1, 1), cB + hstep + kstep, voffB);
        PG8_WAIT_V(6); PG8_BAR;
    }
    for (;;) {
        const bool has_next = S.next(ui + 1, nxt);
        const char* nA = has_next ? (const char*)g.A + (size_t)nxt.pm * tstepA : cA; const char* nB = has_next ? (const char*)g.Bt + (size_t)nxt.pn * tstep : cB;
        for (int t = 0; t < nt; t += 2) {
            const bool last = (t == nt - 2);
            const char* a1 = cA + (size_t)(t + 1) * kstep;
            const char* a2 = last ? nA : cA + (size_t)(t + 2) * kstep; const char* b2 = last ? nB : cB + (size_t)(t + 2) * kstep;
            const char* a3 = a2 + kstep; const char* b3 = b2 + kstep;
            if (last && has_next) S.a_ready(nxt);
            if constexpr (SP2) {
            PG8_LDB(B0, 0, 0); PG8_LDB(B1, 0, 1); PG8_SCHED; PG8_LDA(At, 0, 0); PG8_STAGE(PG8_SA(1, 1), a1 + hstepA, voffA);
            PG8_WAIT_V(8); PG8_WAIT_L(0); PG8_BAR; PG8_MMA(0, 0, At, B0); PG8_MMA(0, 1, At, B1); PG8_BAR; PG8_SCHED;
            PG8_LDA(At, 0, 1); PG8_STAGE(PG8_SB(0, 0), b2, voffB); PG8_STAGE(PG8_SB(0, 1), b2 + hstep, voffB); PG8_STAGE(PG8_SA(0, 0), a2, voffA);
            PG8_WAIT_V(8); PG8_WAIT_L(0); PG8_BAR; PG8_MMA(1, 0, At, B0); PG8_MMA(1, 1, At, B1); PG8_BAR; PG8_SCHED;
            PG8_LDB(B0, 1, 0); PG8_LDB(B1, 1, 1); PG8_SCHED; PG8_LDA(At, 1, 0); PG8_STAGE(PG8_SA(0, 1), a2 + hstepA, voffA);
            PG8_WAIT_V(8); PG8_WAIT_L(0); PG8_BAR; PG8_MMA(0, 0, At, B0); PG8_MMA(0, 1, At, B1); PG8_BAR; PG8_SCHED;
            PG8_LDA(At, 1, 1); PG8_STAGE(PG8_SB(1, 0), b3, voffB); PG8_STAGE(PG8_SB(1, 1), b3 + hstep, voffB); PG8_STAGE(PG8_SA(1, 0), a3, voffA);
            PG8_WAIT_V(8); PG8_WAIT_L(0); PG8_BAR; PG8_MMA(1, 0, At, B0); PG8_MMA(1, 1, At, B1); PG8_BAR; PG8_SCHED;
            } else {
            PG8_LDB(B0, 0, 0); PG8_SCHED; PG8_LDA(At, 0, 0); PG8_STAGE(PG8_SA(1, 1), a1 + hstepA, voffA);
            PG8_WAIT_L(8); PG8_BAR; PG8_WAIT_L(0); PG8_MMA(0, 0, At, B0); PG8_BAR; PG8_SCHED;
            PG8_LDB(B1, 0, 1); PG8_STAGE(PG8_SB(0, 0), b2, voffB);
            PG8_BAR; PG8_WAIT_L(0); PG8_MMA(0, 1, At, B1); PG8_BAR;
            PG8_LDA(At, 0, 1); PG8_STAGE(PG8_SA(0, 0), a2, voffA);
            PG8_BAR; PG8_WAIT_L(0); PG8_MMA(1, 0, At, B0); PG8_BAR; PG8_SCHED;
            PG8_STAGE(PG8_SB(0, 1), b2 + hstep, voffB);
            PG8_WAIT_V(6); PG8_BAR; PG8_MMA(1, 1, At, B1); PG8_BAR;
            PG8_LDB(B0, 1, 0); PG8_SCHED; PG8_LDA(At, 1, 0); PG8_STAGE(PG8_SA(0, 1), a2 + hstepA, voffA);
            PG8_WAIT_L(8); PG8_BAR; PG8_WAIT_L(0); PG8_MMA(0, 0, At, B0); PG8_BAR; PG8_SCHED;
            PG8_LDB(B1, 1, 1); PG8_STAGE(PG8_SB(1, 0), b3, voffB);
            PG8_BAR; PG8_WAIT_L(0); PG8_MMA(0, 1, At, B1); PG8_BAR;
            PG8_LDA(At, 1, 1); PG8_STAGE(PG8_SA(1, 0), a3, voffA);
            PG8_BAR; PG8_WAIT_L(0); PG8_MMA(1, 0, At, B0); PG8_BAR; PG8_SCHED;
            PG8_STAGE(PG8_SB(1, 1), b3 + hstep, voffB);
            PG8_WAIT_V(6); PG8_BAR; PG8_MMA(1, 1, At, B1); PG8_BAR;
            }
        }
        if constexpr (ALIGN_EPI) { if (wr == 0) PG8_BAR; }
        if constexpr (!Epi::AFTER_DRAIN) { E(acc, cur, wr, wc, fr, fq); S.done(cur); }
        if (!has_next) break;
#pragma unroll
        for (int a = 0; a < 2; ++a)
#pragma unroll
            for (int b = 0; b < 2; ++b)
#pragma unroll
                for (int m = 0; m < 4; ++m)
#pragma unroll
                    for (int n = 0; n < 2; ++n) acc[a][b][m][n] = (f32x4){0.f, 0.f, 0.f, 0.f};
        cur = nxt; cA = nA; cB = nB; ++ui;
        if constexpr (ALIGN_EPI) { if (wr == 1) PG8_BAR; }
    }
    PG8_WAIT_V(0);
    if constexpr (!ALIGN_EPI) { if (wr == 0) PG8_BAR; }
    PG8_BAR;
    if constexpr (Epi::AFTER_DRAIN) { E.fused(acc, cur, wr, wc, fr, fq, lds, wid, lane); S.done(cur); }
#undef PG8_SA
#undef PG8_SB
#undef PG8_STAGE
#undef PG8_LDA
#undef PG8_LDB
#undef PG8_MMA
#undef PG8_WAIT_V
#undef PG8_WAIT_L
#undef PG8_BAR
#undef PG8_SCHED
}
}
#define LAS __attribute__((address_space(3)))
typedef unsigned short bf16;
typedef float f32x4 __attribute__((ext_vector_type(4)));
typedef unsigned u32x4 __attribute__((ext_vector_type(4)));
typedef unsigned u32x2 __attribute__((ext_vector_type(2)));
constexpr int BATCH = 2, SEQ = 8192, DM = 2048, M = BATCH * SEQ, DEPTH = 2;
constexpr int NIN = 3648, NINP = 3840, QR = 384, KVR = 128, NQ = 1536, NKV = 2048, DFF = 8192;
constexpr int C_KROPE = 512, C_QB = 576, C_KB = 1088, C_VB = 1600, C_QC = 2112, C_KC = 2624, C_VC = 3136;
constexpr float EPS = 1e-6f, LOG2E = 1.4426950408889634f;
constexpr size_t MiB = 1u << 20;
constexpr size_t WS_CTL = 0, WS_ROPE = 1 * MiB, WS_PART = 4 * MiB, WS_W = 6 * MiB, W_LAYER = 90 * MiB;
constexpr size_t WO_IN = 0, WO_UQ = 15 * MiB, WO_UKV = 17 * MiB, WO_O = 18 * MiB, WO_UP = 26 * MiB, WO_DN = 58 * MiB;
constexpr size_t WS_XB = 186 * MiB, WS_HN = 250 * MiB, WS_QA = 314 * MiB, WS_KVA = 362 * MiB, WS_HFF = 250 * MiB, WS_END = 506 * MiB;
static_assert((size_t)NINP * DM * 2 <= 15 * MiB && (size_t)NQ * QR * 2 <= 2 * MiB && (size_t)M * NINP * 2 <= 120 * MiB && (size_t)M * NQ * 2 <= 48 * MiB && (size_t)M * DFF * 2 <= 256 * MiB, "ws map");
constexpr int CW_BAR = 4096;
constexpr int LDS_BYTES = 147456, MISC_OFF = 131072;
constexpr int NTHREADS = 512, NWAVES = 8;

typedef float f32x2_t __attribute__((ext_vector_type(2))); typedef __bf16 bf16x2_t __attribute__((ext_vector_type(2)));
__device__ __forceinline__ unsigned cvtpk(float lo, float hi) { f32x2_t v = {lo, hi}; bf16x2_t b = __builtin_convertvector(v, bf16x2_t); return __builtin_bit_cast(unsigned, b); }
__device__ __forceinline__ float wave_sum(float v) {
#pragma unroll
    for (int o = 1; o < 64; o <<= 1) v += __shfl_xor(v, o);
    return v;
}
#define LDS_WAIT() asm volatile("s_waitcnt lgkmcnt(0)" ::: "memory")

__device__ __forceinline__ int dstmap(int mode, int n) {
    if (mode == 1) { if (n >= 512 && n < 576) { const int i = n - 512; return 512 + (i < 32 ? 2 * i : 2 * (i - 32) + 1); } return n; }
    if (mode == 2) { const int hh = n / 192; int r = n - hh * 192; if (r >= 128) { const int i = r - 128; r = 128 + (i < 32 ? 2 * i : 2 * (i - 32) + 1); } return hh * 192 + r; }
    return n;
}
__device__ __forceinline__ void transpose_item(const float* __restrict__ W, int K, int N, const float* __restrict__ g, bf16* __restrict__ WT, int mode, LAS float* scr, int item, int lane) {
    const int nblk = N / 32, kb = item / nblk, nb = item - kb * nblk, k0 = 64 * kb, n0 = 32 * nb;
    f32x4 v[8]; const int kr = lane >> 3, n4 = (lane & 7) * 4;
#pragma unroll
    for (int i = 0; i < 8; ++i) v[i] = *(const f32x4*)(W + (size_t)(k0 + 8 * i + kr) * N + n0 + n4);
#pragma unroll
    for (int i = 0; i < 8; ++i) { const int kk = 8 * i + kr; const float gg = g ? g[k0 + kk] : 1.0f;
        scr[kk * 33 + n4 + 0] = v[i].x * gg; scr[kk * 33 + n4 + 1] = v[i].y * gg; scr[kk * 33 + n4 + 2] = v[i].z * gg; scr[kk * 33 + n4 + 3] = v[i].w * gg; }
    LDS_WAIT(); asm volatile("" ::: "memory");
    const int c = lane & 7;
#pragma unroll
    for (int j = 0; j < 4; ++j) { const int n = (lane >> 3) + 8 * j; const LAS float* s = scr + (8 * c) * 33 + n;
        u32x4 o; o.x = cvtpk(s[0 * 33], s[1 * 33]); o.y = cvtpk(s[2 * 33], s[3 * 33]); o.z = cvtpk(s[4 * 33], s[5 * 33]); o.w = cvtpk(s[6 * 33], s[7 * 33]);
        *(u32x4*)(WT + (size_t)dstmap(mode, n0 + n) * K + k0 + 8 * c) = o; }
    LDS_WAIT(); asm volatile("" ::: "memory");
}
__device__ __forceinline__ void xb_rows_phase(const float* __restrict__ x, bf16* __restrict__ xb, float* __restrict__ part, int gw, int ngw, int lane) {
    for (int mrow = gw; mrow < M; mrow += ngw) {
        const f32x4* xr = (const f32x4*)(x + (size_t)mrow * DM) + 2 * lane;
        f32x4 v[8]; float s = 0.f;
#pragma unroll
        for (int j = 0; j < 4; ++j) { v[2 * j] = xr[128 * j]; v[2 * j + 1] = xr[128 * j + 1]; }
#pragma unroll
        for (int j = 0; j < 8; ++j) s += (v[j].x * v[j].x + v[j].y * v[j].y) + (v[j].z * v[j].z + v[j].w * v[j].w);
        s = wave_sum(s);
        u32x4* o16 = (u32x4*)(xb + (size_t)mrow * DM) + lane;
#pragma unroll
        for (int j = 0; j < 4; ++j) { u32x4 w; w.x = cvtpk(v[2 * j].x, v[2 * j].y); w.y = cvtpk(v[2 * j].z, v[2 * j].w); w.z = cvtpk(v[2 * j + 1].x, v[2 * j + 1].y); w.w = cvtpk(v[2 * j + 1].z, v[2 * j + 1].w); o16[64 * j] = w; }
        if (lane < 32) part[(size_t)mrow * 32 + lane] = lane == 0 ? s : 0.f;
    }
}
__device__ __forceinline__ void panel_rstd_from_part(const float* __restrict__ part, int pm, LAS float* rs, int tid) {
    const int row = tid >> 1, half = tid & 1;
    const f32x4* p = (const f32x4*)(part + ((size_t)pm * 256 + row) * 32 + half * 16);
    const f32x4 a = p[0], b = p[1], c = p[2], d = p[3];
    float sm = ((a.x + a.y) + (a.z + a.w)) + ((b.x + b.y) + (b.z + b.w)) + ((c.x + c.y) + (c.z + c.w)) + ((d.x + d.y) + (d.z + d.w));
    sm += __shfl_xor(sm, 1);
    if (half == 0) rs[row] = 1.0f / sqrtf(sm * (1.f / DM) + EPS);
    __syncthreads();
}
__device__ __forceinline__ void panel_rstd_cqkv(const bf16* __restrict__ proj, int pm, LAS float* rq, LAS float* rkv, int wave, int lane) {
#pragma unroll 4
    for (int i = 0; i < 32; ++i) { const int row = wave * 32 + i;
        const u32x4 w = *((const u32x4*)(proj + ((size_t)pm * 256 + row) * NINP) + lane);
        float sq = 0.f;
#pragma unroll
        for (int e = 0; e < 4; ++e) { const float f0 = __uint_as_float(w[e] << 16), f1 = __uint_as_float(w[e] & 0xffff0000u); sq += f0 * f0 + f1 * f1; }
        const float tq = wave_sum(lane < 48 ? sq : 0.f), tkv = wave_sum(lane < 48 ? 0.f : sq);
        if (lane == 0) { rq[row] = 1.0f / sqrtf(tq * (1.f / QR) + EPS); rkv[row] = 1.0f / sqrtf(tkv * (1.f / KVR) + EPS); } }
    __syncthreads();
}
__device__ __forceinline__ void final_norm_phase(const bf16* __restrict__ xb, float* __restrict__ out, const float* __restrict__ g, int gw, int ngw, int lane) {
    for (int mrow = gw; mrow < M; mrow += ngw) {
        const u32x4* xr = (const u32x4*)(xb + (size_t)mrow * DM) + lane; const f32x4* gr = (const f32x4*)g + 2 * lane;
        f32x4 v[8]; float s = 0.f;
#pragma unroll
        for (int j = 0; j < 4; ++j) { const u32x4 w = xr[64 * j];
            v[2 * j] = (f32x4){__uint_as_float(w.x << 16), __uint_as_float(w.x & 0xffff0000u), __uint_as_float(w.y << 16), __uint_as_float(w.y & 0xffff0000u)};
            v[2 * j + 1] = (f32x4){__uint_as_float(w.z << 16), __uint_as_float(w.z & 0xffff0000u), __uint_as_float(w.w << 16), __uint_as_float(w.w & 0xffff0000u)}; }
#pragma unroll
        for (int j = 0; j < 8; ++j) s += (v[j].x * v[j].x + v[j].y * v[j].y) + (v[j].z * v[j].z + v[j].w * v[j].w);
        const float rstd = 1.0f / sqrtf(wave_sum(s) * (1.f / DM) + EPS);
        f32x4* orow = (f32x4*)(out + (size_t)mrow * DM) + 2 * lane;
#pragma unroll
        for (int j = 0; j < 4; ++j) { orow[128 * j] = v[2 * j] * rstd * gr[128 * j]; orow[128 * j + 1] = v[2 * j + 1] * rstd * gr[128 * j + 1]; }
    }
}
__device__ __forceinline__ const float* arg_in(int i) { asm volatile("" : "+s"(i)); return ((const float* const __attribute__((address_space(4)))*)__builtin_amdgcn_kernarg_segment_ptr())[i]; }
constexpr int I_IN = (DM / 64) * (NIN / 32), I_UQ = (QR / 64) * (NQ / 32), I_UKV = (KVR / 64) * (NKV / 32), I_O = (DM / 64) * (DM / 32), I_UP = (DM / 64) * (DFF / 32), I_DN = (DFF / 64) * (DM / 32);
constexpr int I_LAYER = I_IN + I_UQ + I_UKV + I_O + I_UP + I_DN;
__device__ __forceinline__ unsigned char* arg_ws() { int o = 19; asm volatile("" : "+s"(o)); return ((unsigned char* const __attribute__((address_space(4)))*)__builtin_amdgcn_kernarg_segment_ptr())[o]; }
constexpr int I_EARLY = I_IN + I_UQ + I_UKV;
constexpr int N_DEFER = (I_LAYER - I_EARLY) + (DEPTH - 1) * I_LAYER;
constexpr int CONV_CHUNK = 64, N_CONV_CHUNKS = (N_DEFER + CONV_CHUNK - 1) / CONV_CHUNK;
__device__ __forceinline__ void convert_item(int l, int r, unsigned char* ws, LAS float* scr, int lane) {
    unsigned char* wl = ws + WS_W + (size_t)l * W_LAYER;
    if (r < I_IN) { transpose_item(arg_in(2) + (size_t)l * DM * NIN, DM, NIN, arg_in(1) + l * DM, (bf16*)(wl + WO_IN), 1, scr, r, lane); return; } r -= I_IN;
    if (r < I_UQ) { transpose_item(arg_in(5) + (size_t)l * QR * NQ, QR, NQ, arg_in(3) + l * QR, (bf16*)(wl + WO_UQ), 2, scr, r, lane); return; } r -= I_UQ;
    if (r < I_UKV) { transpose_item(arg_in(6) + (size_t)l * KVR * NKV, KVR, NKV, arg_in(4) + l * KVR, (bf16*)(wl + WO_UKV), 0, scr, r, lane); return; } r -= I_UKV;
    if (r < I_O) { transpose_item(arg_in(13) + (size_t)l * DM * DM, DM, DM, nullptr, (bf16*)(wl + WO_O), 0, scr, r, lane); return; } r -= I_O;
    if (r < I_UP) { transpose_item(arg_in(15) + (size_t)l * DM * DFF, DM, DFF, arg_in(14) + l * DM, (bf16*)(wl + WO_UP), 0, scr, r, lane); return; } r -= I_UP;
    transpose_item(arg_in(16) + (size_t)l * DFF * DM, DFF, DM, nullptr, (bf16*)(wl + WO_DN), 0, scr, r, lane);
}
namespace att {
typedef short bf16x8 __attribute__((ext_vector_type(8)));
typedef short s16x4 __attribute__((ext_vector_type(4)));
typedef short v4i16_t __attribute__((ext_vector_type(4)));
typedef float f32x16 __attribute__((ext_vector_type(16)));
constexpr int VS = 320, VBYTES = 64 * VS, KMAXB = 64 * (192 * 2 + 16);
constexpr int V_OFF0 = 0, V_OFF1 = VBYTES, K_OFF0 = 2 * VBYTES;
constexpr int QPARK_OFF = K_OFF0 + 2 * KMAXB;
constexpr int STASH_OFF = K_OFF0 + 2 * 64 * (64 * 2 + 16);
static_assert(QPARK_OFF + 8 * 4096 <= MISC_OFF && STASH_OFF + 65536 <= MISC_OFF, "attention LDS");
__device__ __forceinline__ s16x4 vtr(const LAS unsigned char* p) { return __builtin_bit_cast(s16x4, __builtin_amdgcn_ds_read_tr16_b64_v4i16((LAS v4i16_t*)p)); }
#define MFMA32(a, b, c) __builtin_amdgcn_mfma_f32_32x32x16_bf16((a), (b), (c), 0, 0, 0)
#define ATT_THR 8.0f

template <int DQK, int BIAS, bool AHEAD = true>
__device__ __forceinline__ void flash_loop(LAS unsigned char* lds, const bf16* __restrict__ Qrow,
        const bf16* __restrict__ Ka, int kap, const bf16* __restrict__ Kb, int kbp, const bf16* __restrict__ Vp, int vpp,
        int t_lo, int t_hi, int wt_lo, int wt_hi, float c, float slope2, const LAS float* tab, int qpos,
        f32x16 (&o)[4], float& m_io, float& l_io, const float* __restrict__ kn2row = nullptr, int q0blk = 0) {
    int tid_ = threadIdx.x; asm volatile("" : "+v"(tid_));
    const int tid = tid_, lane = tid & 63, hi = lane >> 5, l32 = lane & 31;
    constexpr int KS = DQK * 2 + 16, CPR = DQK / 8, NKC = DQK / 64, NDS = DQK / 16;
    constexpr int NQR = (DQK == 192 && AHEAD) ? 8 : NDS;
    bf16x8 qf[NQR];
#pragma unroll
    for (int ds = 0; ds < NQR; ++ds) qf[ds] = *(const bf16x8*)(Qrow + 16 * ds + 8 * hi);
    LAS unsigned char* qpark = lds + QPARK_OFF + (tid >> 6) * 4096 + lane * 16;
#pragma unroll
    for (int ds = NQR; ds < NDS; ++ds) *(LAS bf16x8*)(qpark + (ds - NQR) * 1024) = *(const bf16x8*)(Qrow + 16 * ds + 8 * hi);
    constexpr int K_OFF1 = K_OFF0 + 64 * KS;
    LAS float* red = (LAS float*)(lds + MISC_OFF + 1600);
    if (BIAS == 1) {
        float qn2 = 0.f;
#pragma unroll
        for (int ds = 0; ds < NQR; ++ds)
#pragma unroll
            for (int e = 0; e < 8; ++e) { const float v = __uint_as_float(((unsigned)(unsigned short)qf[ds][e]) << 16); qn2 += v * v; }
        qn2 += __shfl_xor(qn2, 32);
#pragma unroll
        for (int sh = 1; sh < 32; sh <<= 1) qn2 = fmaxf(qn2, __shfl_xor(qn2, sh));
        if (lane == 0) red[tid >> 6] = qn2;
    }
    int tlo = t_lo;
    const int t_dec = (BIAS == 1 && kn2row != nullptr && t_hi - 4 > t_lo + 1) ? t_hi - 4 : -1;
    unsigned koffB[NKC]; int kdst[NKC];
#pragma unroll
    for (int i = 0; i < NKC; ++i) {
        if (DQK == 64) { const int row = tid >> 3, ch = tid & 7; koffB[i] = (unsigned)(row * kap + ch * 8) * 2u; kdst[i] = row * KS + ch * 16; }
        else if (DQK == 192 && i == 2) { const int row = tid >> 3, ch = tid & 7; koffB[i] = (unsigned)(row * kbp + ch * 8) * 2u; kdst[i] = row * KS + (16 + ch) * 16; }
        else { const int cidx = tid + NTHREADS * i, row = cidx >> 4, ch = cidx & 15; koffB[i] = (unsigned)(row * kap + ch * 8) * 2u; kdst[i] = row * KS + ch * 16; } }
    unsigned voffB[2]; int vdst[2];
#pragma unroll
    for (int i = 0; i < 2; ++i) { const int cidx = tid + NTHREADS * i, row = cidx >> 4, ch = cidx & 15; voffB[i] = (unsigned)(row * vpp + ch * 8) * 2u; vdst[i] = row * VS + ch * 16; }
    u32x4 kreg[NKC], vreg[2];
    float m = m_io, l = l_io;
    const int koffL = l32 * KS + hi * 16;
    const int i16 = lane & 15, tq = i16 >> 2, tp = i16 & 3, blk = (lane >> 4) & 1;
    const int voffL = (4 * hi + tq) * VS + (16 * blk + 4 * tp) * 2;
    f32x16 sc0, sc1, sn0, sn1;
#define ATT_KLD(dst0, dst1, ds_) do { if ((ds_) < NDS) { dst0 = *(const LAS bf16x8*)(kq_ + (ds_) * 32); dst1 = *(const LAS bf16x8*)(kq_ + 32 * KS + (ds_) * 32); } } while (0)
#define ATT_QLD(ds_) ((ds_) < NQR ? qf[(ds_) < NQR ? (ds_) : 0] : *(const LAS bf16x8*)(qpark + ((ds_) - NQR) * 1024))
#define ATT_QK(S0, S1, kb_) do { const LAS unsigned char* kq_ = lds + ((kb_) ? K_OFF1 : K_OFF0) + koffL; \
        bf16x8 ka_[3][2]; \
        ATT_KLD(ka_[0][0], ka_[0][1], 0); ATT_KLD(ka_[1][0], ka_[1][1], 1); \
        __builtin_amdgcn_s_setprio(1); \
        _Pragma("unroll") for (int r_ = 0; r_ < 16; ++r_) { S0[r_] = 0.f; S1[r_] = 0.f; } \
        _Pragma("unroll") for (int ds_ = 0; ds_ < NDS; ++ds_) { \
            ATT_KLD(ka_[(ds_ + 2) % 3][0], ka_[(ds_ + 2) % 3][1], ds_ + 2); \
            const bf16x8 q_ = ATT_QLD(ds_); \
            S0 = MFMA32(ka_[ds_ % 3][0], q_, S0); S1 = MFMA32(ka_[ds_ % 3][1], q_, S1); \
            __builtin_amdgcn_sched_barrier(0); } __builtin_amdgcn_s_setprio(0); } while (0)
#define ATT_SMPV(S0, S1, tt_) do { \
        const int dq_ = qpos - 64 * (tt_) - 4 * hi; \
        _Pragma("unroll") for (int r_ = 0; r_ < 16; ++r_) { const int kr_ = (r_ & 3) + 8 * (r_ >> 2); \
            if (BIAS == 0) { }   \
            else if (BIAS == 1) { const float fd_ = (float)dq_; S0[r_] = S0[r_] * c - slope2 * fabsf(fd_ - (float)kr_); S1[r_] = S1[r_] * c - slope2 * fabsf(fd_ - (float)(kr_ + 32)); } \
            else { const int d0_ = dq_ - kr_; const int i0_ = min(max(d0_, -63), 256) + 63, i1_ = min(max(d0_ - 32, -63), 256) + 63; S0[r_] = S0[r_] * c + tab[i0_]; S1[r_] = S1[r_] * c + tab[i1_]; } } \
        float mx_ = fmaxf(S0[0], S1[0]); \
        _Pragma("unroll") for (int r_ = 1; r_ < 16; ++r_) mx_ = fmaxf(mx_, fmaxf(S0[r_], S1[r_])); \
        mx_ = fmaxf(mx_, __shfl_xor(mx_, 32)); \
        if (BIAS == 0) mx_ *= c; \
          \
        if (__any(mx_ - m > ATT_THR)) { const float mn2_ = fmaxf(m, mx_), alpha_ = __builtin_amdgcn_exp2f(m - mn2_); m = mn2_; l *= alpha_; \
            _Pragma("unroll") for (int d_ = 0; d_ < 4; ++d_) _Pragma("unroll") for (int r_ = 0; r_ < 16; ++r_) o[d_][r_] *= alpha_; } \
        const float mn_ = m; \
        float ps_ = 0.f; \
        _Pragma("unroll") for (int r_ = 0; r_ < 16; ++r_) { \
            if (BIAS == 0) { S0[r_] = __builtin_amdgcn_exp2f(__builtin_fmaf(S0[r_], c, -mn_)); S1[r_] = __builtin_amdgcn_exp2f(__builtin_fmaf(S1[r_], c, -mn_)); } \
            else { S0[r_] = __builtin_amdgcn_exp2f(S0[r_] - mn_); S1[r_] = __builtin_amdgcn_exp2f(S1[r_] - mn_); } \
            ps_ += S0[r_] + S1[r_]; } \
        l += ps_; \
        u32x4 pw_[4]; \
        _Pragma("unroll") for (int e_ = 0; e_ < 4; ++e_) { pw_[0][e_] = cvtpk(S0[2 * e_], S0[2 * e_ + 1]); pw_[1][e_] = cvtpk(S0[8 + 2 * e_], S0[8 + 2 * e_ + 1]); \
                                                          pw_[2][e_] = cvtpk(S1[2 * e_], S1[2 * e_ + 1]); pw_[3][e_] = cvtpk(S1[8 + 2 * e_], S1[8 + 2 * e_ + 1]); } \
        const LAS unsigned char* vb_ = lds + (((tt_) & 1) ? V_OFF1 : V_OFF0) + voffL; \
        s16x4 vl_[4], vh_[4]; \
        _Pragma("unroll") for (int i_ = 0; i_ < 3; ++i_) { vl_[i_] = vtr(vb_ + i_ * 64); vh_[i_] = vtr(vb_ + 8 * VS + i_ * 64); } \
        _Pragma("unroll") for (int i_ = 0; i_ < 16; ++i_) { const int st_ = i_ >> 2, d_ = i_ & 3; \
            if (i_ + 3 < 16) { const int s2_ = (i_ + 3) >> 2, d2_ = (i_ + 3) & 3; vl_[(i_ + 3) & 3] = vtr(vb_ + (16 * s2_) * VS + d2_ * 64); vh_[(i_ + 3) & 3] = vtr(vb_ + (16 * s2_ + 8) * VS + d2_ * 64); } \
            const bf16x8 vf_ = __builtin_shufflevector(vl_[i_ & 3], vh_[i_ & 3], 0, 1, 2, 3, 4, 5, 6, 7); \
            o[d_] = MFMA32(vf_, __builtin_bit_cast(bf16x8, pw_[st_]), o[d_]); } } while (0)
#define ATT_LOADK(t) do { _Pragma("unroll") for (int i_ = 0; i_ < NKC; ++i_) { const char* b_ = (DQK == 192 && i_ == 2) ? (const char*)(Kb + (size_t)(t) * 64 * kbp) : (const char*)(Ka + (size_t)(t) * 64 * kap); \
        kreg[i_] = *(const u32x4*)(b_ + koffB[i_]); } } while (0)
#define ATT_LOADV(t) do { const char* b_ = (const char*)(Vp + (size_t)(t) * 64 * vpp); _Pragma("unroll") for (int i_ = 0; i_ < 2; ++i_) vreg[i_] = *(const u32x4*)(b_ + voffB[i_]); } while (0)
#define ATT_STOREK(b) do { _Pragma("unroll") for (int i_ = 0; i_ < NKC; ++i_) *(LAS u32x4*)(lds + ((b) ? K_OFF1 : K_OFF0) + kdst[i_]) = kreg[i_]; } while (0)
#define ATT_STOREV(b) do { _Pragma("unroll") for (int i_ = 0; i_ < 2; ++i_) *(LAS u32x4*)(lds + ((b) ? V_OFF1 : V_OFF0) + vdst[i_]) = vreg[i_]; } while (0)
    const bool late = (__builtin_amdgcn_readfirstlane(tid >> 6) & 1) != 0;
#define ATT_ACT(tt_) (((tt_) >= wt_lo) && ((tt_) <= wt_hi))
#define ATT_SB() __builtin_amdgcn_sched_barrier(0)
    if constexpr (!AHEAD) {
        ATT_LOADK(t_hi); ATT_LOADV(t_hi); ATT_STOREK(t_hi & 1); ATT_STOREV(t_hi & 1);
        if (t_hi > tlo) { ATT_LOADK(t_hi - 1); ATT_LOADV(t_hi - 1); }
        __syncthreads();
        for (int t = t_hi; t >= tlo; --t) {
            if (t > tlo) { ATT_STOREK((t - 1) & 1); ATT_STOREV((t - 1) & 1); }
            if (t - 1 > tlo) { ATT_LOADK(t - 2); ATT_LOADV(t - 2); }
            if (ATT_ACT(t)) { ATT_QK(sc0, sc1, t & 1); ATT_SMPV(sc0, sc1, t); }
            asm volatile("s_waitcnt lgkmcnt(0)\n\ts_barrier" ::: "memory");
        }
    } else {
    ATT_LOADK(t_hi); ATT_LOADV(t_hi); ATT_STOREK(t_hi & 1); ATT_STOREV(t_hi & 1); __syncthreads();
    ATT_LOADK(t_hi - 1);
    if (ATT_ACT(t_hi)) ATT_QK(sc0, sc1, t_hi & 1);
    ATT_STOREK((t_hi - 1) & 1); __syncthreads();
    for (int t = t_hi; t > tlo; --t) {
        ATT_LOADK(max(t - 2, tlo)); ATT_LOADV(t - 1);
        ATT_SB();
        if (!late) { if (ATT_ACT(t - 1)) ATT_QK(sn0, sn1, (t - 1) & 1); }
        ATT_SB();
        if (ATT_ACT(t)) ATT_SMPV(sc0, sc1, t);
        ATT_SB();
        if (late) { if (ATT_ACT(t - 1)) ATT_QK(sn0, sn1, (t - 1) & 1); }
        ATT_SB();
        ATT_STOREK(t & 1); ATT_STOREV((t - 1) & 1);
        if (BIAS == 1) { if (t == t_dec) { float wm = m;
#pragma unroll
            for (int sh = 1; sh < 32; sh <<= 1) wm = fminf(wm, __shfl_xor(wm, sh));
            if (lane == 0) red[8 + (tid >> 6)] = wm; } }
        __syncthreads();
        if (BIAS == 1) { if (t == t_dec) {
            float qmax2 = red[0], mlo = red[8];
#pragma unroll
            for (int w = 1; w < 8; ++w) { qmax2 = fmaxf(qmax2, red[w]); mlo = fminf(mlo, red[8 + w]); }
            bool dead[2];
#pragma unroll
            for (int i = 0; i < 2; ++i) { const int tt = lane + 64 * i; const float kn2 = kn2row[tt];
                const float ub = sqrtf(qmax2 * kn2) * c * 1.001f - slope2 * (float)(q0blk - 64 * tt - 63) - mlo;
                dead[i] = (tt < t) && (ub <= -160.f); }
            const unsigned long long d0 = __ballot(dead[0]), d1 = __ballot(dead[1]);
            const int ndead = (~d0 != 0ull) ? (__ffsll((long long)~d0) - 1) : ((~d1 != 0ull) ? 64 + (__ffsll((long long)~d1) - 1) : 128);
            tlo = min(max(ndead, tlo), t - 1);
        } }
        sc0 = sn0; sc1 = sn1;
    }
    if (ATT_ACT(tlo)) ATT_SMPV(sc0, sc1, tlo);
    __syncthreads();
    }
#undef ATT_ACT
#undef ATT_SB
#undef ATT_QK
#undef ATT_KLD
#undef ATT_QLD
#undef ATT_SMPV
#undef ATT_LOADK
#undef ATT_LOADV
#undef ATT_STOREK
#undef ATT_STOREV
    m_io = m; l_io = l;
}
__device__ __forceinline__ void store_pairs(bf16* __restrict__ dst, int d, int ap, int hi, unsigned ax, unsigned ay, unsigned bx, unsigned by) {
    const auto rx = __builtin_amdgcn_permlane32_swap(ax, bx, false, false), ry = __builtin_amdgcn_permlane32_swap(ay, by, false, false);
    u32x4 w; w.x = rx[0]; w.y = ry[0]; w.z = rx[1]; w.w = ry[1];
    *(u32x4*)(dst + 32 * d + 16 * ap + 8 * hi) = w;
}
__device__ __forceinline__ void store_o(bf16* __restrict__ dst, const f32x16 (&o)[4], float inv, int hi) {
#pragma unroll
    for (int d = 0; d < 4; ++d)
#pragma unroll
        for (int ap = 0; ap < 2; ++ap) { const int r0 = 8 * ap;
            store_pairs(dst, d, ap, hi, cvtpk(o[d][r0] * inv, o[d][r0 + 1] * inv), cvtpk(o[d][r0 + 2] * inv, o[d][r0 + 3] * inv),
                                        cvtpk(o[d][r0 + 4] * inv, o[d][r0 + 5] * inv), cvtpk(o[d][r0 + 6] * inv, o[d][r0 + 7] * inv)); }
}
struct Ptrs { const bf16* proj; const bf16* qA; const bf16* kvA; bf16* mixed; const float* subln; const float* relb; const float* kn2; float lam, lam_init; };

__device__ __forceinline__ void unit_mla(LAS unsigned char* lds, const Ptrs& P, int b, int h, int qb) {
    int tid_ = threadIdx.x; asm volatile("" : "+v"(tid_));
    const int tid = tid_, lane = tid & 63, hi = lane >> 5, l32 = lane & 31, wid = __builtin_amdgcn_readfirstlane(tid >> 6);
    const size_t rowb = (size_t)b * SEQ; const int q0 = qb * 256, qrow = q0 + 32 * wid + l32;
    f32x16 o[4];
#pragma unroll
    for (int d = 0; d < 4; ++d)
#pragma unroll
        for (int r = 0; r < 16; ++r) o[d][r] = 0.f;
    float m = -1e30f, l = 0.f;
    flash_loop<192, 0, false>(lds, P.qA + (rowb + qrow) * NQ + h * 192, P.kvA + rowb * NKV + h * 256, NKV, P.proj + rowb * NINP + C_KROPE, NINP, P.kvA + rowb * NKV + h * 256 + 128, NKV,
                       0, q0 / 64 + 3, 0, q0 / 64 + (wid >> 1), 0.07216878364870323f * LOG2E, 0.f, nullptr, qrow, o, m, l);
    l += __shfl_xor(l, 32);
    store_o(P.mixed + (rowb + qrow) * DM + h * 128, o, 1.0f / l, hi);
}
__device__ __forceinline__ void unit_diff(LAS unsigned char* lds, const Ptrs& P, int b, int h, int qb) {
    int tid_ = threadIdx.x; asm volatile("" : "+v"(tid_));
    const int tid = tid_, lane = tid & 63, hi = lane >> 5, l32 = lane & 31, wid = __builtin_amdgcn_readfirstlane(tid >> 6);
    const size_t rowb = (size_t)b * SEQ; const int q0 = qb * 256, qrow = q0 + 32 * wid + l32;
    const float slope2 = exp2f(-2.0f * (float)(h + 1)) * LOG2E, c = 0.125f * LOG2E;
    const bf16* qp = P.proj + (rowb + qrow) * NINP + C_QB + h * 128; const bf16* kp = P.proj + rowb * NINP + C_KB + h * 128; const bf16* vp = P.proj + rowb * NINP + C_VB + h * 128;
    const int t_hi = q0 / 64 + 3, wt_hi = q0 / 64 + (wid >> 1);
    f32x16 o[4];
#pragma unroll
    for (int d = 0; d < 4; ++d)
#pragma unroll
        for (int r = 0; r < 16; ++r) o[d][r] = 0.f;
    float m = -1e30f, l = 0.f;
    const float* kn2 = P.kn2 + ((b * 4 + h) * 2) * 128;
    flash_loop<64, 1>(lds, qp + 64, kp + 64, NINP, kp, NINP, vp, NINP, 0, t_hi, 0, wt_hi, c, slope2, nullptr, qrow, o, m, l, kn2 + 128, q0);
    l += __shfl_xor(l, 32);
    LAS unsigned* stash = (LAS unsigned*)(lds + STASH_OFF) + tid;
    { const float f = P.lam / l;
#pragma unroll
      for (int d = 0; d < 4; ++d)
#pragma unroll
          for (int e = 0; e < 8; ++e) { stash[(d * 8 + e) * NTHREADS] = cvtpk(o[d][2 * e] * f, o[d][2 * e + 1] * f); o[d][2 * e] = 0.f; o[d][2 * e + 1] = 0.f; } }
    m = -1e30f; l = 0.f;
    flash_loop<64, 1>(lds, qp, kp, NINP, kp, NINP, vp, NINP, 0, t_hi, 0, wt_hi, c, slope2, nullptr, qrow, o, m, l, kn2, q0);
    l += __shfl_xor(l, 32);
    const float inv = 1.0f / l; float ss = 0.f;
#pragma unroll
    for (int d = 0; d < 4; ++d)
#pragma unroll
        for (int e = 0; e < 8; ++e) { const unsigned w = stash[(d * 8 + e) * NTHREADS];
            const float v0 = o[d][2 * e] * inv - __uint_as_float(w << 16), v1 = o[d][2 * e + 1] * inv - __uint_as_float(w & 0xffff0000u);
            o[d][2 * e] = v0; o[d][2 * e + 1] = v1; ss += v0 * v0 + v1 * v1; }
    ss += __shfl_xor(ss, 32);
    const float rs = (1.0f / sqrtf(ss * (1.f / 128.f) + EPS)) * (1.0f - P.lam_init);
    bf16* dst = P.mixed + (rowb + qrow) * DM + 1024 + h * 128;
#pragma unroll
    for (int d = 0; d < 4; ++d)
#pragma unroll
        for (int ap = 0; ap < 2; ++ap) { const int r0 = 8 * ap;
            const f32x4 g0 = *(const f32x4*)(P.subln + 32 * d + 16 * ap + 4 * hi), g1 = *(const f32x4*)(P.subln + 32 * d + 16 * ap + 8 + 4 * hi);
            store_pairs(dst, d, ap, hi, cvtpk(o[d][r0] * rs * g0[0], o[d][r0 + 1] * rs * g0[1]), cvtpk(o[d][r0 + 2] * rs * g0[2], o[d][r0 + 3] * rs * g0[3]),
                                        cvtpk(o[d][r0 + 4] * rs * g1[0], o[d][r0 + 5] * rs * g1[1]), cvtpk(o[d][r0 + 6] * rs * g1[2], o[d][r0 + 7] * rs * g1[3])); }
}
__device__ __forceinline__ void unit_band(LAS unsigned char* lds, const Ptrs& P, int b, int h, int qb) {
    int tid_ = threadIdx.x; asm volatile("" : "+v"(tid_));
    const int tid = tid_, lane = tid & 63, hi = lane >> 5, l32 = lane & 31, wid = __builtin_amdgcn_readfirstlane(tid >> 6);
    const size_t rowb = (size_t)b * SEQ; const int q0 = qb * 256, qrow = q0 + 32 * wid + l32;
    LAS float* tab = (LAS float*)(lds + MISC_OFF + 256);
    if (tid < 320) tab[tid] = P.relb[h * 320 + tid] * LOG2E;
    const int c0 = q0 / 64, cw = c0 + (wid >> 1);
    f32x16 o[4];
#pragma unroll
    for (int d = 0; d < 4; ++d)
#pragma unroll
        for (int r = 0; r < 16; ++r) o[d][r] = 0.f;
    float m = -1e30f, l = 0.f;
    const bf16* kp = P.proj + rowb * NINP + C_KC + h * 128;
    flash_loop<128, 2>(lds, P.proj + (rowb + qrow) * NINP + C_QC + h * 128, kp, NINP, kp, NINP, P.proj + rowb * NINP + C_VC + h * 128, NINP,
                       max(c0 - 8, 0), c0 + 3, max(cw - 8, 0), cw, 0.08838834764831845f * LOG2E, 0.f, tab, qrow, o, m, l);
    l += __shfl_xor(l, 32);
    store_o(P.mixed + (rowb + qrow) * DM + 1536 + h * 128, o, 1.0f / l, hi);
}
__device__ __forceinline__ int next_item(volatile LAS int* s_item, unsigned* ctr) {
    if (threadIdx.x == 0) *s_item = (int)atomicAdd(ctr, 1u);
    __syncthreads();
    const int item = __builtin_amdgcn_readfirstlane(*s_item);
    __syncthreads();
    return item;
}
__device__ __forceinline__ void attention_phase(LAS unsigned char* lds, const Ptrs& P, unsigned* ctr, int n_conv) {
    volatile LAS int* s_item = (volatile LAS int*)(lds + MISC_OFF);
    const int n_groups = n_conv > 0 ? 128 : 0, n_mixed = n_groups * 13;
    for (;;) {
        const int e = next_item(s_item, ctr);
        int item;
        if (e < n_mixed) { const int g = e / 13, r = e - g * 13;
            if (r >= 8) {
                int tid_ = threadIdx.x; asm volatile("" : "+v"(tid_));
                const int lane = tid_ & 63, wave = __builtin_amdgcn_readfirstlane(tid_ >> 6); LAS float* scr = (LAS float*)(lds + wave * 16384);
                const int c = 5 * g + (r - 8); unsigned char* ws = arg_ws();
                if (c < n_conv) {
#pragma unroll 1
                    for (int k = 0; k < CONV_CHUNK / NWAVES; ++k) { const int d = CONV_CHUNK * c + wave + NWAVES * k;
                        if (d < N_DEFER) { if (d < I_LAYER - I_EARLY) convert_item(0, I_EARLY + d, ws, scr, lane); else { const int d1 = d - (I_LAYER - I_EARLY); convert_item(d1 / I_LAYER + 1, d1 % I_LAYER, ws, scr, lane); } } }
                }
                continue;
            }
            item = 8 * g + r;
        } else item = e - n_mixed + 8 * n_groups;
        if (item >= 1024) break;
        if (item >= 696 && item < 952) { const int ci = item - 696; unit_band(lds, P, (ci >> 2) & 1, ci & 3, ci >> 3); }
        else { const int idx = item < 696 ? item : item - 256; const int qb = 31 - idx / 24, j = idx % 24;
            if (j < 16) unit_mla(lds, P, j >> 3, j & 7, qb); else unit_diff(lds, P, (j - 16) >> 2, (j - 16) & 3, qb); }
    }
}
#undef MFMA32
}
#define XB_TMO      128
#define XB_XCNT(j)  (256  + 64 * (j))
#define XB_XSUB(j)  (1280 + 64 * (j))
#define XB_XGEN(j)  (2304 + 64 * (j))
#define XB_TOP      3328
#define XB_TOPGEN   3392
#define XCD_BAR_WORDS 3456
#define XB_SPIN_CAP (1u << 18)

__device__ __forceinline__ unsigned xb_ld(unsigned* p)              { return __hip_atomic_load(p, __ATOMIC_RELAXED, __HIP_MEMORY_SCOPE_AGENT); }
__device__ __forceinline__ unsigned xb_add(unsigned* p, unsigned v) { return __hip_atomic_fetch_add(p, v, __ATOMIC_RELAXED, __HIP_MEMORY_SCOPE_AGENT); }
__device__ __forceinline__ unsigned xb_xcc_id() { return (unsigned)__builtin_amdgcn_s_getreg((3 << 11) | 20) & 0xFu; }
#define XB_SPIN(cond, bar) do { unsigned _sp = 0; while (cond) { __builtin_amdgcn_s_sleep(1); \
    if ((++_sp & 255u) == 0u) { if (xb_ld(&(bar)[XB_TMO])) break; if (_sp > XB_SPIN_CAP) { atomicAdd(&(bar)[XB_TMO], 1u); break; } } } } while (0)

struct XcdBarrier {
    unsigned* bar; unsigned x;
    volatile LAS unsigned* st;
};

__device__ __forceinline__ XcdBarrier xcd_barrier_post(unsigned* bar, volatile LAS unsigned* st) {
    XcdBarrier b; b.bar = bar; b.x = xb_xcc_id(); b.st = st;
    if (threadIdx.x == 0) (void)xb_add(&bar[XB_XCNT(b.x)], 1u);
    return b;
}
__device__ __forceinline__ void xcd_barrier_complete(unsigned* bar, unsigned x, unsigned& nloc, unsigned& nx) {
    const unsigned G = gridDim.x * gridDim.y * gridDim.z;
    unsigned sum, cnt, mine, sp = 0u;
    for (;;) {
        sum = 0u; cnt = 0u; mine = 0u;
#pragma unroll
        for (unsigned j = 0; j < 16; ++j) { const unsigned c = xb_ld(&bar[XB_XCNT(j)]); sum += c; cnt += (c > 0u) ? 1u : 0u; mine = (j == x) ? c : mine; }
        if (sum == G) break;
        __builtin_amdgcn_s_sleep(1);
        if ((++sp & 255u) == 0u) { if (xb_ld(&bar[XB_TMO])) break; if (sp > XB_SPIN_CAP) { atomicAdd(&bar[XB_TMO], 1u); break; } }
    }
    nloc = mine > 0u ? mine : 1u; nx = cnt > 0u ? cnt : 1u;
}

__device__ __forceinline__ void xcd_barrier(const XcdBarrier& b) {
    asm volatile("s_waitcnt vmcnt(0)" ::: "memory");
    __syncthreads();
    if (threadIdx.x == 0) {
        unsigned* bar = b.bar; asm volatile("" : "+s"(bar)); unsigned bx = b.x; asm volatile("" : "+s"(bx));
        __builtin_amdgcn_s_waitcnt(0);
        unsigned nloc = b.st[0], nx = b.st[1];
        if (nloc == 0u) { xcd_barrier_complete(bar, bx, nloc, nx); b.st[0] = nloc; b.st[1] = nx; }
        const unsigned old = xb_add(&bar[XB_XSUB(bx)], 1u);
        const unsigned gen = old / nloc;
        if (old + 1u == (gen + 1u) * nloc) {
            __builtin_amdgcn_fence(__ATOMIC_RELEASE, "agent");
            asm volatile("s_waitcnt vmcnt(0)" ::: "memory");
            const unsigned og = xb_add(&bar[XB_TOP], 1u);
            const unsigned tg = og / nx;
            if (og + 1u == (tg + 1u) * nx) xb_add(&bar[XB_TOPGEN], 1u);
            else XB_SPIN(xb_ld(&bar[XB_TOPGEN]) == tg, bar);
            __builtin_amdgcn_fence(__ATOMIC_ACQUIRE, "agent");
            xb_add(&bar[XB_XGEN(bx)], 1u);
            asm volatile("s_waitcnt vmcnt(0)" ::: "memory");
        } else {
            XB_SPIN(xb_ld(&bar[XB_XGEN(bx)]) == gen, bar);
            __builtin_amdgcn_fence(__ATOMIC_ACQUIRE, "agent");
            asm volatile("s_waitcnt vmcnt(0)" ::: "memory");
        }
    }
    __syncthreads();
}

struct Args { const float* in[18]; float* out; unsigned char* ws; int ph_lo, ph_hi; };
constexpr int N_PHASES = 2 + 6 * DEPTH;

__global__ void __launch_bounds__(NTHREADS, 2) fwd_mega(Args a) {
    extern __shared__ __attribute__((aligned(16))) unsigned char lds_raw[];
    LAS unsigned char* lds = (LAS unsigned char*)lds_raw;
    cg::grid_group grid = cg::this_grid();
    const int G = gridDim.x;
    unsigned char* ws = a.ws;
    float* xres = a.out;
    bf16* hn = (bf16*)(ws + WS_HN); bf16* proj = (bf16*)a.out;        bf16* qA = (bf16*)(ws + WS_QA); bf16* kvA = (bf16*)(ws + WS_KVA); bf16* hff = (bf16*)(ws + WS_HFF);
    bf16* xb = (bf16*)(ws + WS_XB); float* part = (float*)(ws + WS_PART);
    float* rope_tab = (float*)(ws + WS_ROPE);
    unsigned* ctl = (unsigned*)(ws + WS_CTL);
    const int lo = a.ph_lo, hi = a.ph_hi;
    if (threadIdx.x < 2) ((volatile LAS unsigned*)(lds + MISC_OFF + 64))[threadIdx.x] = 0u;
    __syncthreads();
    XcdBarrier xbar = xcd_barrier_post(ctl + CW_BAR, (volatile LAS unsigned*)(lds + MISC_OFF + 64));
#ifndef PH_MASK
#define PH_MASK 0x3ff
#endif
#define PH_BEGIN(k) if (((PH_MASK >> PH_SUB) & 1) && lo <= (k) && (k) < hi) { \
        int tid_ = threadIdx.x; asm volatile("" : "+v"(tid_));        \
        int bid_ = blockIdx.x, Go_ = G; asm volatile("" : "+s"(bid_), "+s"(Go_));        \
        const int bid = bid_, Gp = Go_; \
        const int tid = tid_, lane = tid & 63, wave = __builtin_amdgcn_readfirstlane(tid >> 6), gw = bid * NWAVES + wave, ngw = Gp * NWAVES; (void)lane; (void)gw; (void)ngw; (void)tid;
#define PH_END(k) } if (lo <= (k) && (k) + 1 < hi) { if (lo < 0) grid.sync(); else xcd_barrier(xbar); }

#define PH_SUB 9
    PH_BEGIN(0)
#undef PH_SUB
        LAS float* scr = (LAS float*)(lds + wave * 16384);
        for (int it = gw; it < I_EARLY; it += ngw) convert_item(0, it, ws, scr, lane);
        {
            const int gt = blockIdx.x * NTHREADS + tid, ngt = G * NTHREADS;
            constexpr int PADV = (NINP - NIN) * DM * 2 / 16;
            for (int i = gt; i < DEPTH * PADV; i += ngt) { const int l = i / PADV, r = i - l * PADV;
                ((u32x4*)(ws + WS_W + (size_t)l * W_LAYER + WO_IN + (size_t)NIN * DM * 2))[r] = (u32x4){0u, 0u, 0u, 0u}; }
            for (int i = gt; i < SEQ * 32; i += ngt) { const int pos = i >> 5, fi = i & 31;
                double f = 1.0; for (int k = 0; k < fi; ++k) f *= 0.74989420933245582;
                const float inv_freq = (float)f, ang = (float)pos * inv_freq;
                double rev = (double)ang * 0.15915494309189535; rev -= __builtin_rint(rev);
                const float rv = (float)rev;
                ((f32x2_t*)rope_tab)[i] = (f32x2_t){__builtin_amdgcn_cosf(rv), __builtin_amdgcn_sinf(rv)}; }
        }
        xb_rows_phase(arg_in(0), xb, part, gw, ngw, lane);
    PH_END(0)

    LAS float* rs0 = (LAS float*)(lds + MISC_OFF + 2048);
    LAS float* rs1 = rs0 + 256;
#pragma unroll 1
    for (int l = 0; l < DEPTH; ++l) {
        const int pb = 1 + 6 * l;
        unsigned char* wl = ws + WS_W + (size_t)l * W_LAYER;
#define PH_SUB 0
        PH_BEGIN(pb + 0)
#undef PH_SUB
            pg8::Gemm g{xb, (const bf16*)(wl + WO_IN), M, NINP, DM, DM}; pg8::StaticOrder S; S.init(M, NINP, Gp, bid);
            { pg8::Unit u0; S.next(0, u0); panel_rstd_from_part(part, u0.pm, rs0, tid); }
            pg8::EpiBf<0, true> E{proj, NINP, 1 << 20, C_KROPE, rope_tab, rs0};
            pg8::gemm_phase<pg8::EpiBf<0, true>, pg8::StaticOrder, true, true>(lds, g, S, E);
        PH_END(pb + 0)
#define PH_SUB 1
        PH_BEGIN(pb + 1)
#undef PH_SUB
            { pg8::Gemm g{proj, (const bf16*)(wl + WO_UQ), M, NQ, QR, NINP}; pg8::StaticOrder S; S.init(M, NQ, Gp, bid);
              { pg8::Unit u0; S.next(0, u0); panel_rstd_cqkv(proj, u0.pm, rs0, rs1, wave, lane); }
              pg8::EpiBf<0, true> E{qA, NQ, 192, 128, rope_tab, rs0};
              pg8::gemm_phase<pg8::EpiBf<0, true>, pg8::StaticOrder, true, true>(lds, g, S, E); }
            { pg8::Gemm g{proj + QR, (const bf16*)(wl + WO_UKV), M, NKV, KVR, NINP}; pg8::StaticOrder S; S.init(M, NKV, Gp, bid);
              pg8::EpiBf<0, false> E{kvA, NKV, 1, 0, nullptr, rs1};
              pg8::gemm_phase<pg8::EpiBf<0, false>, pg8::StaticOrder, true, true>(lds, g, S, E); }
            {
                float* kn2 = (float*)(ws + WS_CTL + 65536);
                for (int it = gw; it < 2048; it += ngw) { const int bb = it >> 10, hh = (it >> 8) & 3, mp = (it >> 7) & 1, tt = it & 127;
                    const u32x4* kp = (const u32x4*)(proj + ((size_t)bb * SEQ + 64 * tt + lane) * NINP + C_KB + hh * 128 + mp * 64);
                    float sq = 0.f;
#pragma unroll
                    for (int j = 0; j < 8; ++j) { const u32x4 w = kp[j];
#pragma unroll
                        for (int e = 0; e < 4; ++e) { const float f0 = __uint_as_float(w[e] << 16), f1 = __uint_as_float(w[e] & 0xffff0000u); sq += f0 * f0 + f1 * f1; } }
#pragma unroll
                    for (int sh = 1; sh < 64; sh <<= 1) sq = fmaxf(sq, __shfl_xor(sq, sh));
                    if (lane == 0) kn2[it] = sq; }
            }
        PH_END(pb + 1)
#define PH_SUB 2
        PH_BEGIN(pb + 2)
#undef PH_SUB
            att::Ptrs P; P.proj = proj; P.qA = qA; P.kvA = kvA; P.mixed = hn; P.subln = arg_in(11) + l * 128; P.relb = arg_in(12) + l * 4 * 320; P.kn2 = (const float*)(ws + WS_CTL + 65536);
            { const float s1 = wave_sum(arg_in(7)[l * 64 + lane] * arg_in(8)[l * 64 + lane]), s2 = wave_sum(arg_in(9)[l * 64 + lane] * arg_in(10)[l * 64 + lane]);
              P.lam_init = 0.8f - 0.6f * expf(-0.3f * (float)l); P.lam = expf(s1) - expf(s2) + P.lam_init; }
            att::attention_phase(lds, P, ctl + 64 * l, l == 0 ? N_CONV_CHUNKS : 0);
        PH_END(pb + 2)
#define PH_SUB 3
        PH_BEGIN(pb + 3)
#undef PH_SUB
            pg8::Gemm g{hn, (const bf16*)(wl + WO_O), M, DM, DM, DM}; pg8::StaticOrder S; S.init(M, DM, Gp, bid);
            pg8::EpiRes E{xb, part, DM};
            pg8::gemm_phase<pg8::EpiRes, pg8::StaticOrder, true, true>(lds, g, S, E);
        PH_END(pb + 3)
#define PH_SUB 4
        PH_BEGIN(pb + 4)
#undef PH_SUB
            pg8::Gemm g{xb, (const bf16*)(wl + WO_UP), M, DFF, DM, DM}; pg8::StaticOrder S; S.init(M, DFF, Gp, bid);
            { pg8::Unit u0; S.next(0, u0); panel_rstd_from_part(part, u0.pm, rs0, tid); }
            pg8::EpiBf<2, false> E{hff, DFF, 1, 0, nullptr, rs0};
            pg8::gemm_phase<pg8::EpiBf<2, false>, pg8::StaticOrder, true, true>(lds, g, S, E);
        PH_END(pb + 4)
#define PH_SUB 5
        PH_BEGIN(pb + 5)
#undef PH_SUB
            pg8::Gemm g{hff, (const bf16*)(wl + WO_DN), M, DM, DFF, DFF}; pg8::StaticOrder S; S.init(M, DM, Gp, bid);
            pg8::EpiRes E{xb, part, DM};
            pg8::gemm_phase<pg8::EpiRes, pg8::StaticOrder, true, true>(lds, g, S, E);
        PH_END(pb + 5)
    }
#define PH_SUB 6
    PH_BEGIN(N_PHASES - 1)
#undef PH_SUB
        final_norm_phase(xb, xres, arg_in(17), gw, ngw, lane);
    PH_END(N_PHASES - 1)
#undef PH_BEGIN
#undef PH_END
}

#ifndef MK_PER_PHASE
#define MK_PER_PHASE 0
#endif
extern "C" void kernel_launch(void* const* d_in, const int* in_sizes, int n_in, void* d_out, int out_size, void* d_ws, size_t ws_size, hipStream_t stream) {
    static int grid = 0;
    if (grid == 0) {
        if (n_in != 18 || out_size != M * DM || ws_size < WS_END) { fprintf(stderr, "kernel_launch: unexpected problem (n_in %d out %d ws %zu)\n", n_in, out_size, ws_size); grid = -1; return; }
        int dev = 0, cus = 0, per_cu = 0;
        (void)hipGetDevice(&dev); (void)hipDeviceGetAttribute(&cus, hipDeviceAttributeMultiprocessorCount, dev);
        if (hipFuncSetAttribute((const void*)fwd_mega, hipFuncAttributeMaxDynamicSharedMemorySize, LDS_BYTES) != hipSuccess) { fprintf(stderr, "kernel_launch: hipFuncSetAttribute failed\n"); grid = -1; return; }
        if (hipOccupancyMaxActiveBlocksPerMultiprocessor(&per_cu, (const void*)fwd_mega, NTHREADS, LDS_BYTES) != hipSuccess || per_cu < 1) per_cu = 1;
        (void)hipGetLastError();
        grid = cus * per_cu; if (grid <= 0) grid = 256;
    }
    if (grid < 0) return;
    (void)hipMemsetAsync((char*)d_ws + WS_CTL, 0, 32768, stream);
    Args a{};
    for (int i = 0; i < 18; ++i) a.in[i] = (const float*)d_in[i];
    a.out = (float*)d_out; a.ws = (unsigned char*)d_ws;
#if MK_PER_PHASE
    for (int p = 0; p < N_PHASES; ++p) { a.ph_lo = p; a.ph_hi = p + 1; hipLaunchKernelGGL(fwd_mega, dim3(grid), dim3(NTHREADS), LDS_BYTES, stream, a); }
#else
    a.ph_lo = 0; a.ph_hi = N_PHASES;
    void* args[] = {&a};
    hipError_t e = hipLaunchCooperativeKernel((const void*)fwd_mega, dim3(grid), dim3(NTHREADS), args, LDS_BYTES, stream);
    if (e != hipSuccess) fprintf(stderr, "kernel_launch: cooperative launch failed: %s (grid %d)\n", hipGetErrorString(e), grid);
#endif
}
```
